# Optimizing an MI355X kernel written in HIP

```python
import math
import jax
import jax.numpy as jnp
from jax import lax
import numpy as np


D_MODEL = 1024
BATCH = 2
SEQ = 8192
DEPTH = 2

GRID_W = 64
CTX_LEN = 256
POOL_W = 256
POOL_WINDOWS = (2, 4, 8, 16)
POOL_GROUP = POOL_W // len(POOL_WINDOWS)
CONV_W = 256
CONV_K = 31
DIFF_W = 256
DIFF_HEADS = 4
DIFF_DH = DIFF_W // (2 * DIFF_HEADS)
NA_W = 256
NA_HEADS = 4
NA_DH = NA_W // NA_HEADS
NA_ROWS = 8
NA_COLS = 16
D_MIX = POOL_W + CONV_W + DIFF_W + NA_W
D_FF = 2816
N_MOD = 9
ROPE_BASE = 10000.0
EPS = 1e-6
LN_EPS = 1e-5
Q_BLOCK = 128
NEG_INF = -1e30
OFF_POOL = 0
OFF_CONV = OFF_POOL + POOL_W
OFF_DIFF = OFF_CONV + 2 * CONV_W
OFF_NA = OFF_DIFF + 3 * DIFF_W
D_IN = OFF_NA + 3 * NA_W

kernel_name = "hybrid_parallel_mixer_dit_block"


def rmsnorm(x, g):
    xf = x.astype(jnp.float32)
    y = xf * lax.rsqrt(jnp.mean(xf * xf, axis=-1, keepdims=True) + EPS)
    return (y * g.astype(jnp.float32)).astype(x.dtype)


def layernorm(x, g, b):
    xf = x.astype(jnp.float32)
    mu = jnp.mean(xf, axis=-1, keepdims=True)
    var = jnp.mean(jnp.square(xf - mu), axis=-1, keepdims=True)
    y = (xf - mu) * lax.rsqrt(var + LN_EPS)
    return (y * g.astype(jnp.float32) + b.astype(jnp.float32)).astype(x.dtype)


def modulate_in(x, g, shift, scale):
    return rmsnorm(x, g) * (1 + scale) + shift


def swiglu(y, w_in, w_out):
    a, gt = jnp.split(y @ w_in, 2, axis=-1)
    return (jax.nn.silu(a) * gt) @ w_out


def axial_rope(x, n):
    dh = x.shape[-1]
    half = dh // 2
    nf = half // 2
    inv = jnp.power(ROPE_BASE, -jnp.arange(nf, dtype=jnp.float32) / nf)
    t = jnp.arange(n)
    out = []
    for pos, seg in ((t // GRID_W, x[..., :half]), (t % GRID_W, x[..., half:])):
        ang = pos.astype(jnp.float32)[:, None] * inv[None, :]
        cos = jnp.cos(ang).astype(x.dtype)
        sin = jnp.sin(ang).astype(x.dtype)
        s1, s2 = seg[..., :nf], seg[..., nf:]
        out += [s1 * cos - s2 * sin, s2 * cos + s1 * sin]
    return jnp.concatenate(out, axis=-1)


def pool_mixer(u, pool_w, pool_scale):
    n = u.shape[1]
    uf = u.astype(jnp.float32)
    cs = jnp.concatenate([jnp.zeros_like(uf[:, :1]), jnp.cumsum(uf, axis=1)], axis=1)
    t = jnp.arange(n)
    outs = []
    for gi, w in enumerate(POOL_WINDOWS):
        sl = slice(gi * POOL_GROUP, (gi + 1) * POOL_GROUP)
        lo = jnp.clip(t - w // 2, 0, n)
        hi = jnp.clip(t + w - w // 2, 0, n)
        csg = cs[..., sl]
        mean = (csg[:, hi] - csg[:, lo]) / (hi - lo).astype(jnp.float32)[None, :, None]
        d = (mean - uf[..., sl]).astype(u.dtype)
        outs.append(d @ pool_w[gi])
    return jnp.concatenate(outs, axis=-1) * pool_scale


def conv_module(u, dw, dw_b, ln_g, ln_b, pw, pw_b):
    a, g = jnp.split(u, 2, axis=-1)
    h = a * jax.nn.sigmoid(g)
    h = lax.conv_general_dilated(h, dw[:, None, :].astype(h.dtype), window_strides=(1,),
                                 padding=[(CONV_K // 2, CONV_K // 2)],
                                 dimension_numbers=('NWC', 'WIO', 'NWC'),
                                 feature_group_count=CONV_W) + dw_b
    h = jax.nn.silu(layernorm(h, ln_g, ln_b))
    return h @ pw + pw_b


def diff_attend(q, k, v, lam):
    b, h2, nq, _ = q.shape
    s = jnp.einsum('bhqd,bhkd->bhqk', q, k).astype(jnp.float32)
    p = jax.nn.softmax(s, axis=-1).reshape(b, h2 // 2, 2, nq, k.shape[2])
    w = p[:, :, 0] - lam * p[:, :, 1]
    return jnp.einsum('bhqk,bhkd->bhqd', w.astype(v.dtype), v)


def diff_mixer(zl, zc, lam_params, subln_g, li, need_ctx):
    b, n, _ = zl.shape
    lam_init = 0.8 - 0.6 * math.exp(-0.3 * li)
    lp = lam_params.astype(jnp.float32)
    lam = jnp.exp(jnp.sum(lp[0] * lp[1])) - jnp.exp(jnp.sum(lp[2] * lp[3])) + lam_init
    scale = DIFF_DH ** -0.5

    def split(z):
        m = z.shape[1]
        q = z[..., :DIFF_W].reshape(b, m, 2 * DIFF_HEADS, DIFF_DH).transpose(0, 2, 1, 3)
        k = z[..., DIFF_W:2 * DIFF_W].reshape(b, m, 2 * DIFF_HEADS, DIFF_DH).transpose(0, 2, 1, 3)
        v = z[..., 2 * DIFF_W:].reshape(b, m, DIFF_HEADS, 2 * DIFF_DH).transpose(0, 2, 1, 3)
        return q, k, v

    ql, kl, vl = split(zl)
    qc, kc, vc = split(zc)
    ql = axial_rope(ql, n) * scale
    kl = axial_rope(kl, n)
    k_all = jnp.concatenate([kl, kc], axis=2)
    v_all = jnp.concatenate([vl, vc], axis=2)
    nb = n // Q_BLOCK
    qb = ql.reshape(b, 2 * DIFF_HEADS, nb, Q_BLOCK, DIFF_DH).transpose(2, 0, 1, 3, 4)
    ob = lax.map(lambda qi: diff_attend(qi, k_all, v_all, lam), qb)
    ol = ob.transpose(1, 2, 0, 3, 4).reshape(b, DIFF_HEADS, n, 2 * DIFF_DH)

    def post(o):
        o = rmsnorm(o, subln_g) * (1 - lam_init)
        return o.transpose(0, 2, 1, 3).reshape(b, o.shape[2], DIFF_W)

    out_l = post(ol)
    out_c = post(diff_attend(qc * scale, kc, vc, lam)) if need_ctx else None
    return out_l, out_c


def na_mixer(zl, zc, rpb, need_ctx):
    b, n, _ = zl.shape
    rows = n // GRID_W
    kr = min(NA_ROWS, rows)
    scale = NA_DH ** -0.5

    def split(z):
        m = z.shape[1]
        q, k, v = (z[..., i * NA_W:(i + 1) * NA_W].reshape(b, m, NA_HEADS, NA_DH).transpose(0, 2, 1, 3)
                   for i in range(3))
        return q * scale, k, v

    ql, kl, vl = split(zl)
    qc, kc, vc = split(zc)
    grid = lambda t: t.reshape(b, NA_HEADS, rows, GRID_W, NA_DH)
    r = jnp.arange(rows)
    r_idx = jnp.clip(r - kr // 2, 0, rows - kr)[:, None] + jnp.arange(kr)[None, :]
    kb = grid(kl)[:, :, r_idx]
    vb = grid(vl)[:, :, r_idx]
    col = jnp.arange(GRID_W)
    c0 = jnp.clip(col - NA_COLS // 2, 0, GRID_W - NA_COLS)
    c_valid = (col[None, :] >= c0[:, None]) & (col[None, :] < c0[:, None] + NA_COLS)
    dr = r_idx - r[:, None] + (NA_ROWS - 1)
    dc = jnp.clip(col[None, :] - col[:, None], 1 - NA_COLS, NA_COLS - 1) + (NA_COLS - 1)
    bias = rpb[:, dr[:, None, :, None], dc[None, :, None, :]].astype(jnp.float32)
    qg = grid(ql)
    s_loc = jnp.einsum('bhrqd,bhrjkd->bhrqjk', qg, kb).astype(jnp.float32) + bias[None]
    s_loc = jnp.where(c_valid[:, None, :], s_loc, NEG_INF)
    s_ctx = jnp.einsum('bhrqd,bhcd->bhrqc', qg, kc).astype(jnp.float32)
    n_loc = kr * GRID_W
    s = jnp.concatenate([s_loc.reshape(b, NA_HEADS, rows, GRID_W, n_loc), s_ctx], axis=-1)
    p = jax.nn.softmax(s, axis=-1)
    p_loc = p[..., :n_loc].reshape(b, NA_HEADS, rows, GRID_W, kr, GRID_W).astype(vl.dtype)
    p_ctx = p[..., n_loc:].astype(vl.dtype)
    o = jnp.einsum('bhrqjk,bhrjkd->bhrqd', p_loc, vb) + jnp.einsum('bhrqc,bhcd->bhrqd', p_ctx, vc)
    merge = lambda t: t.transpose(0, 2, 1, 3).reshape(b, t.shape[2], NA_W)
    out_l = merge(o.reshape(b, NA_HEADS, n, NA_DH))
    out_c = None
    if need_ctx:
        pc = jax.nn.softmax(jnp.einsum('bhqd,bhkd->bhqk', qc, kc).astype(jnp.float32), axis=-1)
        out_c = merge(jnp.einsum('bhqk,bhkd->bhqd', pc.astype(vc.dtype), vc))
    return out_l, out_c


def token_mixer(yl, yc, lp, li, need_ctx):
    zl = yl @ lp['w_in']
    zc = yc @ lp['w_in']
    conv_args = (lp['conv_dw'], lp['conv_dw_b'], lp['conv_ln_g'], lp['conv_ln_b'], lp['conv_pw'], lp['conv_pw_b'])
    pool_l = pool_mixer(zl[..., OFF_POOL:OFF_CONV], lp['pool_w'], lp['pool_scale'])
    conv_l = conv_module(zl[..., OFF_CONV:OFF_DIFF], *conv_args)
    diff_l, diff_c = diff_mixer(zl[..., OFF_DIFF:OFF_NA], zc[..., OFF_DIFF:OFF_NA],
                                lp['diff_lambda'], lp['diff_subln_g'], li, need_ctx)
    na_l, na_c = na_mixer(zl[..., OFF_NA:], zc[..., OFF_NA:], lp['na_rpb'], need_ctx)
    out_l = jnp.concatenate([pool_l, conv_l, diff_l, na_l], axis=-1) @ lp['w_out']
    out_c = None
    if need_ctx:
        pool_c = pool_mixer(zc[..., OFF_POOL:OFF_CONV], lp['pool_w'], lp['pool_scale'])
        conv_c = conv_module(zc[..., OFF_CONV:OFF_DIFF], *conv_args)
        out_c = jnp.concatenate([pool_c, conv_c, diff_c, na_c], axis=-1) @ lp['w_out']
    return out_l, out_c


def trunk_layer(xl, xc, c, c_ctx, lp, li, need_ctx):
    b = c.shape[0]
    ml_all = (jax.nn.silu(c) @ lp['w_mod'] + lp['b_mod']).reshape(b, 1, N_MOD, D_MODEL)
    ml = [ml_all[:, :, i] for i in range(N_MOD)]
    mc = (jax.nn.silu(c_ctx) @ lp['w_mod'] + lp['b_mod']).reshape(N_MOD, D_MODEL)
    g = lp['g_norm']
    f_in, f_out = lp['ffn_in'], lp['ffn_out']
    xl = xl + 0.5 * ml[2] * swiglu(modulate_in(xl, g[0], ml[0], ml[1]), f_in[0], f_out[0])
    xc = xc + 0.5 * mc[2] * swiglu(modulate_in(xc, g[0], mc[0], mc[1]), f_in[0], f_out[0])
    ol, oc = token_mixer(modulate_in(xl, g[1], ml[3], ml[4]), modulate_in(xc, g[1], mc[3], mc[4]), lp, li, need_ctx)
    xl = xl + ml[5] * ol
    xl = xl + 0.5 * ml[8] * swiglu(modulate_in(xl, g[2], ml[6], ml[7]), f_in[1], f_out[1])
    if need_ctx:
        xc = xc + mc[5] * oc
        xc = xc + 0.5 * mc[8] * swiglu(modulate_in(xc, g[2], mc[6], mc[7]), f_in[1], f_out[1])
    return xl, xc


def setup_inputs(seed: int = 0) -> dict:
    key = jax.random.key(seed)
    ks = jax.random.split(key, 23)
    nrm = lambda k, shape, s: jax.random.normal(k, shape, jnp.float32) * s
    L, D = DEPTH, D_MODEL
    return {
        'x': nrm(ks[0], (BATCH, SEQ, D), 1.0),
        'c': nrm(ks[1], (BATCH, D), 1.0),
        'ctx': nrm(ks[2], (BATCH, CTX_LEN, D), 1.0),
        'c_ctx': nrm(ks[3], (D,), 1.0),
        'w_mod': nrm(ks[4], (L, D, N_MOD * D), 0.5 * D ** -0.5),
        'b_mod': nrm(ks[5], (L, N_MOD * D), 0.02),
        'g_norm': 1.0 + nrm(ks[6], (L, 3, D), 0.1),
        'ffn_in': nrm(ks[7], (L, 2, D, 2 * D_FF), D ** -0.5),
        'ffn_out': nrm(ks[8], (L, 2, D_FF, D), D_FF ** -0.5),
        'w_in': nrm(ks[9], (L, D, D_IN), D ** -0.5),
        'w_out': nrm(ks[10], (L, D_MIX, D), D_MIX ** -0.5),
        'pool_w': nrm(ks[11], (L, len(POOL_WINDOWS), POOL_GROUP, POOL_GROUP), POOL_GROUP ** -0.5),
        'pool_scale': 1.0 + nrm(ks[12], (L, POOL_W), 0.1),
        'conv_dw': nrm(ks[13], (L, CONV_K, CONV_W), CONV_K ** -0.5),
        'conv_dw_b': nrm(ks[14], (L, CONV_W), 0.02),
        'conv_ln_g': 1.0 + nrm(ks[15], (L, CONV_W), 0.1),
        'conv_ln_b': nrm(ks[16], (L, CONV_W), 0.02),
        'conv_pw': nrm(ks[17], (L, CONV_W, CONV_W), CONV_W ** -0.5),
        'conv_pw_b': nrm(ks[18], (L, CONV_W), 0.02),
        'diff_lambda': nrm(ks[19], (L, 4, DIFF_DH), 0.1),
        'diff_subln_g': 1.0 + nrm(ks[20], (L, 2 * DIFF_DH), 0.1),
        'na_rpb': nrm(ks[21], (L, NA_HEADS, 2 * NA_ROWS - 1, 2 * NA_COLS - 1), 0.1),
        'g_final': 1.0 + nrm(ks[22], (D,), 0.1),
    }


def reference(x, c, ctx, c_ctx, w_mod, b_mod, g_norm, ffn_in, ffn_out, w_in, w_out, pool_w, pool_scale,
              conv_dw, conv_dw_b, conv_ln_g, conv_ln_b, conv_pw, conv_pw_b, diff_lambda, diff_subln_g,
              na_rpb, g_final):
    xl, xc = x, ctx
    for li in range(DEPTH):
        lp = {
            'w_mod': w_mod[li], 'b_mod': b_mod[li], 'g_norm': g_norm[li],
            'ffn_in': ffn_in[li], 'ffn_out': ffn_out[li], 'w_in': w_in[li], 'w_out': w_out[li],
            'pool_w': pool_w[li], 'pool_scale': pool_scale[li],
            'conv_dw': conv_dw[li], 'conv_dw_b': conv_dw_b[li], 'conv_ln_g': conv_ln_g[li],
            'conv_ln_b': conv_ln_b[li], 'conv_pw': conv_pw[li], 'conv_pw_b': conv_pw_b[li],
            'diff_lambda': diff_lambda[li], 'diff_subln_g': diff_subln_g[li], 'na_rpb': na_rpb[li],
        }
        xl, xc = trunk_layer(xl, xc, c, c_ctx, lp, li, li < DEPTH - 1)
    return rmsnorm(xl, g_final)
```

```cpp
#include <hip/hip_runtime.h>
#include <hip/hip_cooperative_groups.h>
#include <cstdio>
#include <cstdint>
#include <type_traits>
#include <cstddef>
namespace cg = cooperative_groups;
#ifndef MK_SPLIT
#define MK_SPLIT 0
#endif
__device__ __forceinline__ int tid_now() { int t = threadIdx.x; asm volatile("" : "+v"(t)); return t; }
namespace pg8 {
#define PG8_LAS __attribute__((address_space(3)))
typedef unsigned short bf16_t;
typedef short bf16x8 __attribute__((ext_vector_type(8)));
typedef float f32x4 __attribute__((ext_vector_type(4)));
typedef unsigned u32x4 __attribute__((ext_vector_type(4)));
constexpr int BM = 256, BK = 64, HALF = 128, HTB = HALF * BK * 2  , STAGE_BYTES = 8 * HTB, NXCD = 8, WGM = 8;

__host__ __device__ __forceinline__ int lds_byte(int r, int c) { const int st = (r >> 4) * 2 + (c >> 5), rr = r & 15, cc = c & 31, ob = rr * 64 + cc * 2; return st * 1024 + (ob ^ (((ob >> 9) & 1) << 5)); }
__host__ __device__ __forceinline__ void stage_rc(int b, int& R, int& C) { const int st = b / 1024, sb = b % 1024, swz = sb ^ (((sb >> 9) & 1) << 5); R = (st >> 1) * 16 + swz / 64; C = (st & 1) * 32 + (swz % 64) / 2; }
__host__ __device__ __forceinline__ int perm32(int rho) { const int n = rho >> 4, i = rho & 15; return 8 * (i >> 2) + 4 * n + (i & 3); }

struct Unit { int pm, pn; };
struct Gemm { const bf16_t* A; const bf16_t* Bt; int M, N, K, lda, ldb, apn; };

struct StaticOrder {
    int nM, nN, nwg, G, c;
    __host__ __device__ void init(int M, int N, int G_, int c_) { nM = M / BM; nN = N / BM; nwg = nM * nN; G = G_; c = c_; }
    __host__ __device__ bool next(int i, Unit& u) const {
        const long L = (long)i * G + c; if (L >= nwg) return false;
        int wgid = (int)L; { const int q = nwg / NXCD, r = nwg % NXCD, xcd = wgid % NXCD, off = wgid / NXCD; wgid = (xcd < r ? xcd * (q + 1) : r * (q + 1) + (xcd - r) * q) + off; }
        const int nig = WGM * nN, gid = wgid / nig, fm = gid * WGM, gsz = (nM - fm) < WGM ? (nM - fm) : WGM;
        u.pm = fm + ((wgid % nig) % gsz); u.pn = (wgid % nig) / gsz; return true;
    }
    __device__ __forceinline__ void a_ready(const Unit&) const {}
    __device__ __forceinline__ void done(const Unit&) const {}
};
template <class Epi, class Sched, bool ALIGN_EPI = false, bool SP2 = false>
__device__ __forceinline__ void gemm_phase(PG8_LAS unsigned char* lds, const Gemm g, const Sched& S, const Epi& E) {
    const int tid = tid_now(), wid = __builtin_amdgcn_readfirstlane(tid >> 6), lane = tid & 63, wr = wid >> 2, wc = wid & 3, fr = lane & 15, fq = lane >> 4;
    const int K = g.K, nt = K / BK;
    unsigned voffA[2], voffB[2];
#pragma unroll
    for (int i = 0; i < 2; ++i) { int R, C; stage_rc(tid * 16 + i * 8192, R, C); const int Rb = Epi::PERM ? ((R & ~31) + perm32(R & 31)) : R;
        voffA[i] = (unsigned)(R * g.lda + C) * 2u; voffB[i] = (unsigned)(Rb * g.ldb + C) * 2u; }
    const size_t kstep = (size_t)(BK * 2);
    const size_t hstepA = (size_t)HALF * g.lda * 2, hstepB = (size_t)HALF * g.ldb * 2;
    const size_t tstepA = 2 * hstepA, tstepB = 2 * hstepB;
    const unsigned ldsw = (unsigned)wid * 1024u;
    const int aoff = lds_byte(wr * 64 + fr, fq * 8), boff = lds_byte(wc * 32 + fr, fq * 8);
#define PG8_SA(b, h) (((b) * 2 + (h)) * HTB)
#define PG8_SB(b, h) ((4 + (b) * 2 + (h)) * HTB)
#define PG8_STAGE(bufoff, gbase, voff) do { _Pragma("unroll") for (int _i = 0; _i < 2; ++_i) \
        __builtin_amdgcn_global_load_lds((const unsigned*)((const char*)(gbase) + (voff)[_i]), (PG8_LAS unsigned*)(lds + (bufoff) + ldsw + _i * 8192), 16, 0, 0); } while (0)
#define PG8_LDA(dst, b, h) do { _Pragma("unroll") for (int m = 0; m < 4; ++m) _Pragma("unroll") for (int k = 0; k < 2; ++k) dst[m][k] = *(const PG8_LAS bf16x8*)(lds + PG8_SA(b, h) + aoff + m * 2048 + k * 1024); } while (0)
#define PG8_LDB(dst, b, h) do { _Pragma("unroll") for (int n = 0; n < 2; ++n) _Pragma("unroll") for (int k = 0; k < 2; ++k) dst[n][k] = *(const PG8_LAS bf16x8*)(lds + PG8_SB(b, h) + boff + n * 2048 + k * 1024); } while (0)
#define PG8_MMA(ai, bj, At, Bt) do { __builtin_amdgcn_s_setprio(1); _Pragma("unroll") for (int m = 0; m < 4; ++m) _Pragma("unroll") for (int n = 0; n < 2; ++n) _Pragma("unroll") for (int k = 0; k < 2; ++k) \
        acc[ai][bj][m][n] = __builtin_amdgcn_mfma_f32_16x16x32_bf16(Bt[n][k], At[m][k], acc[ai][bj][m][n], 0, 0, 0); __builtin_amdgcn_s_setprio(0); } while (0)
#define PG8_WAIT_V(n) asm volatile("s_waitcnt vmcnt(" #n ")" ::: "memory")
#define PG8_WAIT_L(n) asm volatile("s_waitcnt lgkmcnt(" #n ")" ::: "memory")
#define PG8_BAR __builtin_amdgcn_s_barrier()
#define PG8_SCHED __builtin_amdgcn_sched_barrier(0)
    Unit cur, nxt; int ui = 0;
    if (!S.next(0, cur)) return;
    f32x4 acc[2][2][4][2];
#pragma unroll
    for (int a = 0; a < 2; ++a)
#pragma unroll
        for (int b = 0; b < 2; ++b)
#pragma unroll
            for (int m = 0; m < 4; ++m)
#pragma unroll
                for (int n = 0; n < 2; ++n) acc[a][b][m][n] = (f32x4){0.f, 0.f, 0.f, 0.f};
    bf16x8 At[4][2], B0[2][2], B1[2][2];
    const char* cA = (const char*)g.A + (size_t)cur.pm * tstepA + (size_t)cur.pn * g.apn; const char* cB = (const char*)g.Bt + (size_t)cur.pn * tstepB;
    S.a_ready(cur);
    if constexpr (SP2) {
        PG8_STAGE(PG8_SB(0, 0), cB, voffB); PG8_STAGE(PG8_SB(0, 1), cB + hstepB, voffB); PG8_STAGE(PG8_SA(0, 0), cA, voffA); PG8_STAGE(PG8_SA(0, 1), cA + hstepA, voffA);
        if (wr == 1) PG8_BAR;
        PG8_WAIT_V(2); PG8_BAR;
        PG8_STAGE(PG8_SB(1, 0), cB + kstep, voffB); PG8_STAGE(PG8_SA(1, 0), cA + kstep, voffA); PG8_STAGE(PG8_SB(1, 1), cB + hstepB + kstep, voffB);
        PG8_WAIT_V(6); PG8_BAR;
    } else {
        PG8_STAGE(PG8_SB(0, 0), cB, voffB); PG8_STAGE(PG8_SA(0, 0), cA, voffA); PG8_STAGE(PG8_SB(0, 1), cB + hstepB, voffB); PG8_STAGE(PG8_SA(0, 1), cA + hstepA, voffA);
        if (wr == 1) PG8_BAR;
        PG8_WAIT_V(4); PG8_BAR;
        PG8_STAGE(PG8_SB(1, 0), cB + kstep, voffB); PG8_STAGE(PG8_SA(1, 0), cA + kstep, voffA); PG8_STAGE(PG8_SB(1, 1), cB + hstepB + kstep, voffB);
        PG8_WAIT_V(6); PG8_BAR;
    }
    for (;;) {
        const bool has_next = S.next(ui + 1, nxt);
        const char* nA = has_next ? (const char*)g.A + (size_t)nxt.pm * tstepA + (size_t)nxt.pn * g.apn : cA; const char* nB = has_next ? (const char*)g.Bt + (size_t)nxt.pn * tstepB : cB;
        for (int t = 0; t < nt; t += 2) {
            const bool last = (t == nt - 2);
            const char* a1 = cA + (size_t)(t + 1) * kstep;
            const char* a2 = last ? nA : cA + (size_t)(t + 2) * kstep; const char* b2 = last ? nB : cB + (size_t)(t + 2) * kstep;
            const char* a3 = a2 + kstep; const char* b3 = b2 + kstep;
            if (last && has_next) S.a_ready(nxt);
            if constexpr (SP2) {
            PG8_LDB(B0, 0, 0); PG8_LDB(B1, 0, 1); PG8_SCHED; PG8_LDA(At, 0, 0); PG8_STAGE(PG8_SA(1, 1), a1 + hstepA, voffA);
            PG8_WAIT_V(8); PG8_WAIT_L(0); PG8_BAR; PG8_MMA(0, 0, At, B0); PG8_MMA(0, 1, At, B1); PG8_BAR; PG8_SCHED;
            PG8_LDA(At, 0, 1); PG8_STAGE(PG8_SB(0, 0), b2, voffB); PG8_STAGE(PG8_SB(0, 1), b2 + hstepB, voffB); PG8_STAGE(PG8_SA(0, 0), a2, voffA);
            PG8_WAIT_V(8); PG8_WAIT_L(0); PG8_BAR; PG8_MMA(1, 0, At, B0); PG8_MMA(1, 1, At, B1); PG8_BAR; PG8_SCHED;
            PG8_LDB(B0, 1, 0); PG8_LDB(B1, 1, 1); PG8_SCHED; PG8_LDA(At, 1, 0); PG8_STAGE(PG8_SA(0, 1), a2 + hstepA, voffA);
            PG8_WAIT_V(8); PG8_WAIT_L(0); PG8_BAR; PG8_MMA(0, 0, At, B0); PG8_MMA(0, 1, At, B1); PG8_BAR; PG8_SCHED;
            PG8_LDA(At, 1, 1); PG8_STAGE(PG8_SB(1, 0), b3, voffB); PG8_STAGE(PG8_SB(1, 1), b3 + hstepB, voffB); PG8_STAGE(PG8_SA(1, 0), a3, voffA);
            PG8_WAIT_V(8); PG8_WAIT_L(0); PG8_BAR; PG8_MMA(1, 0, At, B0); PG8_MMA(1, 1, At, B1); PG8_BAR; PG8_SCHED;
            } else {
            PG8_LDB(B0, 0, 0); PG8_SCHED; PG8_LDA(At, 0, 0); PG8_STAGE(PG8_SA(1, 1), a1 + hstepA, voffA);
            PG8_WAIT_L(8); PG8_BAR; PG8_WAIT_L(0); PG8_MMA(0, 0, At, B0); PG8_BAR; PG8_SCHED;
            PG8_LDB(B1, 0, 1); PG8_STAGE(PG8_SB(0, 0), b2, voffB);
            PG8_BAR; PG8_WAIT_L(0); PG8_MMA(0, 1, At, B1); PG8_BAR;
            PG8_LDA(At, 0, 1); PG8_STAGE(PG8_SA(0, 0), a2, voffA);
            PG8_BAR; PG8_WAIT_L(0); PG8_MMA(1, 0, At, B0); PG8_BAR; PG8_SCHED;
            PG8_STAGE(PG8_SB(0, 1), b2 + hstepB, voffB);
            PG8_WAIT_V(6); PG8_BAR; PG8_MMA(1, 1, At, B1); PG8_BAR;
            PG8_LDB(B0, 1, 0); PG8_SCHED; PG8_LDA(At, 1, 0); PG8_STAGE(PG8_SA(0, 1), a2 + hstepA, voffA);
            PG8_WAIT_L(8); PG8_BAR; PG8_WAIT_L(0); PG8_MMA(0, 0, At, B0); PG8_BAR; PG8_SCHED;
            PG8_LDB(B1, 1, 1); PG8_STAGE(PG8_SB(1, 0), b3, voffB);
            PG8_BAR; PG8_WAIT_L(0); PG8_MMA(0, 1, At, B1); PG8_BAR;
            PG8_LDA(At, 1, 1); PG8_STAGE(PG8_SA(1, 0), a3, voffA);
            PG8_BAR; PG8_WAIT_L(0); PG8_MMA(1, 0, At, B0); PG8_BAR; PG8_SCHED;
            PG8_STAGE(PG8_SB(1, 1), b3 + hstepB, voffB);
            PG8_WAIT_V(6); PG8_BAR; PG8_MMA(1, 1, At, B1); PG8_BAR;
            }
        }
        if constexpr (ALIGN_EPI) { if (wr == 0) PG8_BAR; }
        if constexpr (!Epi::AFTER_DRAIN) { E(acc, cur, wr, wc, fr, fq); S.done(cur); }
        if (!has_next) break;
#pragma unroll
        for (int a = 0; a < 2; ++a)
#pragma unroll
            for (int b = 0; b < 2; ++b)
#pragma unroll
                for (int m = 0; m < 4; ++m)
#pragma unroll
                    for (int n = 0; n < 2; ++n) acc[a][b][m][n] = (f32x4){0.f, 0.f, 0.f, 0.f};
        cur = nxt; cA = nA; cB = nB; ++ui;
        if constexpr (ALIGN_EPI) { if (wr == 1) PG8_BAR; }
    }
    PG8_WAIT_V(0);
    if constexpr (!ALIGN_EPI) { if (wr == 0) PG8_BAR; }
    PG8_BAR;
    if constexpr (Epi::AFTER_DRAIN) { E.fused(acc, cur, wr, wc, fr, fq, lds, wid, lane); S.done(cur); }
#undef PG8_SA
#undef PG8_SB
#undef PG8_STAGE
#undef PG8_LDA
#undef PG8_LDB
#undef PG8_MMA
#undef PG8_WAIT_V
#undef PG8_WAIT_L
#undef PG8_BAR
#undef PG8_SCHED
}
}
#define LAS __attribute__((address_space(3)))
typedef unsigned short bf16_t;
typedef short bf16x8 __attribute__((ext_vector_type(8)));
typedef float f32x4 __attribute__((ext_vector_type(4)));
typedef float f32x2 __attribute__((ext_vector_type(2)));
typedef float f32x16 __attribute__((ext_vector_type(16)));
typedef unsigned u32x4 __attribute__((ext_vector_type(4)));
typedef unsigned u32x2 __attribute__((ext_vector_type(2)));
typedef __bf16 bf16x2_t __attribute__((ext_vector_type(2)));
using pg8::Unit; using pg8::Gemm;

constexpr int D = 1024, NL = 16384, NT = 16896, SEQ = 8192, CTXL = 256, DFF = 2816, DIN = 2304, NMOD = 9;
constexpr int NKEY = 8448;
constexpr size_t NKV_BYTES = (size_t)2 * 4 * 264 * 8192;
constexpr int NCHUNK = 264;
constexpr int LDS_BYTES = 131072, LDS_ALLOC = LDS_BYTES + 512;
constexpr float LOG2E = 1.4426950408889634f;
constexpr float QS_DIFF = 0.17677669529663687f * LOG2E;
constexpr float QS_NA = 0.125f * LOG2E;

struct Params {
    const float *x, *c, *ctx, *c_ctx, *w_mod, *b_mod, *g_norm, *ffn_in, *ffn_out, *w_in, *w_out, *pool_w, *pool_scale,
        *conv_dw, *conv_dw_b, *conv_ln_g, *conv_ln_b, *conv_pw, *conv_pw_b, *diff_lambda, *diff_subln_g, *na_rpb, *g_final;
    float* out;
    bf16_t *WTfi, *WTfo, *WTin, *WTout;
    float *MOD, *ROPE, *ZBIAS, *X;
    bf16_t *Y, *H, *Z, *DQ, *NQ, *KV, *MIX;
    int ph_lo, ph_hi;
};

__device__ __forceinline__ unsigned pk2(float lo, float hi) { f32x2 v = {lo, hi}; bf16x2_t r = __builtin_convertvector(v, bf16x2_t); return __builtin_bit_cast(unsigned, r); }
__device__ __forceinline__ float bflo(unsigned u) { return __uint_as_float(u << 16); }
__device__ __forceinline__ float bfhi(unsigned u) { return __uint_as_float(u & 0xffff0000u); }
__device__ __forceinline__ float bf2f(bf16_t b) { return __uint_as_float((unsigned)b << 16); }
__device__ __forceinline__ float wave_sum(float v) {
#pragma unroll
    for (int o = 1; o < 64; o <<= 1) v += __shfl_xor(v, o);
    return v;
}
__device__ __forceinline__ float fast_sigmoid(float a) { return __builtin_amdgcn_rcpf(1.0f + __expf(-a)); }
__device__ __forceinline__ float ex2(float a) { return __builtin_amdgcn_exp2f(a); }

__device__ __forceinline__ void transpose_tile(const float* __restrict__ src, int N, int k0, int n0, bf16_t* dst, int drow0, int ldd, int dcol0, LAS float* tile, bool zero, const float* nscale = nullptr) {
    const int tid = tid_now();
#pragma unroll
    for (int i = 0; i < 8; ++i) { const int k = i * 8 + (tid >> 6), n = tid & 63; tile[k * 65 + n] = zero ? 0.f : src[(size_t)(k0 + k) * N + n0 + n]; }
    __syncthreads();
    { const int n = tid >> 3, kc = tid & 7; float v[8];
#pragma unroll
      for (int j = 0; j < 8; ++j) v[j] = tile[(kc * 8 + j) * 65 + n];
      if (nscale) { const float sc = nscale[n];
#pragma unroll
        for (int j = 0; j < 8; ++j) v[j] *= sc; }
      u32x4 o; o.x = pk2(v[0], v[1]); o.y = pk2(v[2], v[3]); o.z = pk2(v[4], v[5]); o.w = pk2(v[6], v[7]);
      *(u32x4*)(dst + (size_t)(drow0 + n) * ldd + dcol0 + kc * 8) = o; }
    __syncthreads();
}

__device__ __forceinline__ void prep_phase(const Params& p, LAS unsigned char* lds) {
    const int tid = tid_now(), bid = blockIdx.x, G = gridDim.x;
    LAS float* tile = (LAS float*)lds;
    constexpr int T_FI = 4 * 16 * 88, T_FO = 4 * 44 * 16, T_IN = 2 * 16 * 36, T_OUT = 2 * 128, T_FOLD = 2 * 128;
    constexpr int T_ALL = T_FI + T_FO + T_IN + T_OUT + T_FOLD;
    for (int it = bid; it < T_ALL; it += G) {
        int r = it;
        if (r < T_FI) { const int mat = r / 1408, q = r % 1408, kb = q / 88, nb = q % 88; const int n0 = nb * 64;
            const int j0 = n0 < DFF ? n0 : n0 - DFF; const int drow0 = (j0 >> 7) * 256 + (n0 < DFF ? 0 : 128) + (j0 & 127);
            transpose_tile(p.ffn_in + (size_t)mat * D * 2 * DFF, 2 * DFF, kb * 64, n0, p.WTfi + (size_t)mat * 2 * DFF * D, drow0, D, kb * 64, tile, false); continue; }
        r -= T_FI;
        if (r < T_FO) { const int mat = r / 704, q = r % 704, kb = q / 16, nb = q % 16;
            transpose_tile(p.ffn_out + (size_t)mat * DFF * D, D, kb * 64, nb * 64, p.WTfo + (size_t)mat * D * DFF, nb * 64, DFF, kb * 64, tile, false); continue; }
        r -= T_FO;
        if (r < T_IN) { const int mat = r / 576, q = r % 576, kb = q / 36, nb = q % 36;
            transpose_tile(p.w_in + (size_t)mat * D * DIN, DIN, kb * 64, nb * 64, p.WTin + (size_t)mat * DIN * D, nb * 64, D, kb * 64, tile, false); continue; }
        r -= T_IN;
        if (r < T_OUT) { const int mat = r / 128, q = r % 128, kb = 8 + q / 16, nb = q % 16;
            transpose_tile(p.w_out + (size_t)mat * D * D, D, kb * 64, nb * 64, p.WTout + (size_t)mat * D * D, nb * 64, D, kb * 64, tile, false); continue; }
        r -= T_OUT;
        {
            const int mat = r / 128, q = r % 128, kb = q / 16, nb = q % 16; const int n = tid & 63, kq = tid >> 6;
            const float* wo = p.w_out + (size_t)mat * D * D + nb * 64 + n; float acc[8];
#pragma unroll
            for (int i = 0; i < 8; ++i) acc[i] = 0.f;
            if (kb < 4) { const float* A = p.pool_w + (size_t)(mat * 4 + kb) * 4096 + (kq * 8) * 64; const float* ps = p.pool_scale + mat * 256 + kb * 64;
                for (int j = 0; j < 64; ++j) { const float wv = wo[(size_t)(kb * 64 + j) * D] * ps[j];
#pragma unroll
                    for (int i = 0; i < 8; ++i) acc[i] += A[i * 64 + j] * wv; } }
            else { const float* A = p.conv_pw + (size_t)mat * 65536 + (size_t)((kb - 4) * 64 + kq * 8) * 256;
                for (int j = 0; j < 256; ++j) { const float wv = wo[(size_t)(256 + j) * D];
#pragma unroll
                    for (int i = 0; i < 8; ++i) acc[i] += A[i * 256 + j] * wv; } }
#pragma unroll
            for (int i = 0; i < 8; ++i) tile[(kq * 8 + i) * 65 + n] = acc[i];
            __syncthreads();
            { const int n2 = tid >> 3, kc = tid & 7; float vv[8];
#pragma unroll
              for (int j = 0; j < 8; ++j) vv[j] = tile[(kc * 8 + j) * 65 + n2];
              u32x4 o; o.x = pk2(vv[0], vv[1]); o.y = pk2(vv[2], vv[3]); o.z = pk2(vv[4], vv[5]); o.w = pk2(vv[6], vv[7]);
              *(u32x4*)(p.WTout + (size_t)mat * D * D + (size_t)(nb * 64 + n2) * D + kb * 64 + kc * 8) = o; }
            __syncthreads();
        }
    }
    for (int it = bid; it < 48; it += G) { const int mat = it / 16, nb = it % 16;
        if (tid < 64) { float s = 0.f;
            if (mat < 2) { const float* wo = p.w_out + (size_t)mat * D * D + nb * 64 + tid; const float* pb = p.conv_pw_b + mat * 256;
                for (int j = 0; j < 256; ++j) s += pb[j] * wo[(size_t)(256 + j) * D]; }
            p.ZBIAS[mat * D + nb * 64 + tid] = s; } }
    LAS float* sv = (LAS float*)(lds + 32768);
    LAS float* red = (LAS float*)(lds + 49152);
    for (int i = tid; i < 3072; i += 512) { const float a = i < 2048 ? p.c[i] : p.c_ctx[i - 2048]; sv[i] = a * fast_sigmoid(a); }
    __syncthreads();
    for (int it = bid; it < 288; it += G) {
        const int l = it / 144, n0 = (it % 144) * 64, cc = tid & 63, ks = tid >> 6;
        const float* W = p.w_mod + (size_t)l * D * (NMOD * D) + n0 + cc;
        float a0 = 0.f, a1 = 0.f, a2 = 0.f;
#pragma unroll 8
        for (int k = ks * 128; k < ks * 128 + 128; ++k) { const float w = W[(size_t)k * (NMOD * D)]; a0 += sv[k] * w; a1 += sv[1024 + k] * w; a2 += sv[2048 + k] * w; }
        red[(ks * 3 + 0) * 64 + cc] = a0; red[(ks * 3 + 1) * 64 + cc] = a1; red[(ks * 3 + 2) * 64 + cc] = a2;
        __syncthreads();
        if (tid < 192) { const int v = tid >> 6; float s = 0.f;
#pragma unroll
            for (int q = 0; q < 8; ++q) s += red[(q * 3 + v) * 64 + cc];
            p.MOD[(size_t)(l * 3 + v) * (NMOD * D) + n0 + cc] = s + p.b_mod[(size_t)l * (NMOD * D) + n0 + cc]; }
        __syncthreads();
    }
    if (bid == G - 1) {
        for (int idx = tid; idx < 1024; idx += 512) { const int pos = idx >> 3, i = idx & 7;
            const float inv = exp2f(-(float)i * (13.287712379549449f / 8.0f)); const float ang = (float)pos * inv;
            const float kf = rintf(ang * 0.15915494309189535f); float rr = fmaf(-kf, 6.2831855f, ang); rr = fmaf(-kf, -1.7484555e-7f, rr);
            p.ROPE[idx * 2] = __cosf(rr); p.ROPE[idx * 2 + 1] = __sinf(rr); }
    }
}

__device__ __forceinline__ void norm_phase(const Params& p, int l, int gi, int si, int M, bool first) {
    const int tid = tid_now(), lane = tid & 63; const int NW = gridDim.x * 8;
    const float* g = p.g_norm + (size_t)(l * 3 + gi) * D;
    for (int row = blockIdx.x * 8 + (tid >> 6); row < M; row += NW) {
        const int vec = row < SEQ ? 0 : row < NL ? 1 : 2;
        const float* xr = first ? (row < NL ? p.x + (size_t)row * D : p.ctx + (size_t)(row - NL) * D) : p.X + (size_t)row * D;
        const float* sh = p.MOD + (size_t)(l * 3 + vec) * (NMOD * D) + si * D; const float* sc = sh + D;
        f32x4 v[4]; float ss = 0.f;
#pragma unroll
        for (int j = 0; j < 4; ++j) { v[j] = *(const f32x4*)(xr + j * 256 + lane * 4); ss += v[j].x * v[j].x + v[j].y * v[j].y + v[j].z * v[j].z + v[j].w * v[j].w; }
        ss = wave_sum(ss); const float rs = rsqrtf(ss * (1.0f / D) + 1e-6f);
#pragma unroll
        for (int j = 0; j < 4; ++j) { const int col = j * 256 + lane * 4;
            const f32x4 gv = *(const f32x4*)(g + col), scv = *(const f32x4*)(sc + col), shv = *(const f32x4*)(sh + col);
            const f32x4 y = v[j] * rs * gv * (1.0f + scv) + shv;
            u32x2 o; o.x = pk2(y.x, y.y); o.y = pk2(y.z, y.w); *(u32x2*)(p.Y + (size_t)row * D + col) = o; }
    }
}
__device__ __forceinline__ void final_phase(const Params& p) {
    const int tid = tid_now(), lane = tid & 63; const int NW = gridDim.x * 8;
    for (int row = blockIdx.x * 8 + (tid >> 6); row < NL; row += NW) {
        const float* xr = p.X + (size_t)row * D; f32x4 v[4]; float ss = 0.f;
#pragma unroll
        for (int j = 0; j < 4; ++j) { v[j] = *(const f32x4*)(xr + j * 256 + lane * 4); ss += v[j].x * v[j].x + v[j].y * v[j].y + v[j].z * v[j].z + v[j].w * v[j].w; }
        ss = wave_sum(ss); const float rs = rsqrtf(ss * (1.0f / D) + 1e-6f);
#pragma unroll
        for (int j = 0; j < 4; ++j) { const int col = j * 256 + lane * 4; const f32x4 gv = *(const f32x4*)(p.g_final + col);
            *(f32x4*)(p.out + (size_t)row * D + col) = v[j] * rs * gv; }
    }
}
struct EpiSwiglu {
    static constexpr bool PERM = true, AFTER_DRAIN = false;
    bf16_t* H;
    __device__ __forceinline__ void operator()(const f32x4 (&acc)[2][2][4][2], const Unit& u, int wr_, int wc_, int fr_, int fq_) const {
        const int tq_ = tid_now(); const int wid_ = __builtin_amdgcn_readfirstlane(tq_ >> 6), wr = wid_ >> 2, wc = wid_ & 3, fr = tq_ & 15, fq = (tq_ & 63) >> 4;
        const int row0 = u.pm * 256 + wr * 64 + fr, col0 = u.pn * 128 + wc * 32 + 8 * fq;
#pragma unroll
        for (int ai = 0; ai < 2; ++ai)
#pragma unroll
            for (int m = 0; m < 4; ++m) { float h[8];
#pragma unroll
                for (int n = 0; n < 2; ++n)
#pragma unroll
                    for (int j = 0; j < 4; ++j) { const float a = acc[ai][0][m][n][j], g = acc[ai][1][m][n][j]; h[n * 4 + j] = a * fast_sigmoid(a) * g; }
                u32x4 o; o.x = pk2(h[0], h[1]); o.y = pk2(h[2], h[3]); o.z = pk2(h[4], h[5]); o.w = pk2(h[6], h[7]);
                *(u32x4*)(H + (size_t)(row0 + ai * 128 + m * 16) * DFF + col0) = o; }
    }
};
struct EpiResid {
    static constexpr bool PERM = false, AFTER_DRAIN = false;
    float* X; const float* xl; const float* xc; const float* mod; const float* bo; float coef; int first;
    __device__ __forceinline__ void operator()(const f32x4 (&acc)[2][2][4][2], const Unit& u, int wr_, int wc_, int fr_, int fq_) const {
        const int tq_ = tid_now(); const int wid_ = __builtin_amdgcn_readfirstlane(tq_ >> 6), wr = wid_ >> 2, wc = wid_ & 3, fr = tq_ & 15, fq = (tq_ & 63) >> 4;
        const int pm = u.pm; const int vec = pm < 32 ? 0 : pm < 64 ? 1 : 2;
        const float* gate = mod + (size_t)vec * (NMOD * D);
        const float* xin = first ? (pm < 64 ? xl + (size_t)pm * 256 * D : xc + (size_t)(pm - 64) * 256 * D) : X + (size_t)pm * 256 * D;
        float* xo = X + (size_t)pm * 256 * D;
        const int rl0 = wr * 64 + fr, col0 = u.pn * 256 + wc * 32 + 4 * fq;
#pragma unroll
        for (int bj = 0; bj < 2; ++bj)
#pragma unroll
            for (int n = 0; n < 2; ++n) { const int col = col0 + bj * 128 + n * 16; const f32x4 gv = *(const f32x4*)(gate + col) * coef; const f32x4 bv = *(const f32x4*)(bo + col);
#pragma unroll
                for (int ai = 0; ai < 2; ++ai)
#pragma unroll
                    for (int m = 0; m < 4; ++m) { const size_t off = (size_t)(rl0 + ai * 128 + m * 16) * D + col;
                        const f32x4 xv = *(const f32x4*)(xin + off); *(f32x4*)(xo + off) = xv + gv * (acc[ai][bj][m][n] + bv); } }
    }
};
struct EpiZ {
    static constexpr bool PERM = true, AFTER_DRAIN = false;
    bf16_t *Z, *DQ, *NQ, *KV; const float* rope;
    __device__ __forceinline__ void operator()(const f32x4 (&acc)[2][2][4][2], const Unit& u, int wr_, int wc_, int fr_, int fq_) const {
        const int tq_ = tid_now(); const int wid_ = __builtin_amdgcn_readfirstlane(tq_ >> 6), wr = wid_ >> 2, wc = wid_ & 3, fr = tq_ & 15, fq = (tq_ & 63) >> 4;
        const int pn = u.pn, pm = u.pm; const bool isctx = pm >= 64; const int b = isctx ? pm - 64 : pm >> 5;
#pragma unroll
        for (int ai = 0; ai < 2; ++ai)
#pragma unroll
            for (int m = 0; m < 4; ++m) {
                const int rl = ai * 128 + wr * 64 + m * 16 + fr; const size_t row = (size_t)pm * 256 + rl;
                const int t = isctx ? rl : (pm & 31) * 256 + rl;
                const int key = isctx ? SEQ + rl : t;
                const int chunk = key >> 5, kk = key & 31;
#pragma unroll
                for (int bj = 0; bj < 2; ++bj) {
                    float v[8];
#pragma unroll
                    for (int e = 0; e < 8; ++e) v[e] = acc[ai][bj][m][e >> 2][e & 3];
                    const int cb = bj * 128 + wc * 32 + 8 * fq;
                    if (pn == 3 || pn == 4) {
                        const int pos = fq < 2 ? (t >> 6) : (t & 63); const float* rt = rope + pos * 16; const float sgn = (fq & 1) ? 1.0f : -1.0f;
#pragma unroll
                        for (int e = 0; e < 8; ++e) { const float pv = __shfl_xor(v[e], 16); if (!isctx) { const float cs = rt[2 * e], sn = rt[2 * e + 1]; v[e] = v[e] * cs + sgn * pv * sn; } }
                    }
                    u32x4 o;
                    if (pn == 3) {
#pragma unroll
                        for (int e = 0; e < 8; ++e) v[e] *= QS_DIFF;
                    } else if (pn == 6) {
#pragma unroll
                        for (int e = 0; e < 8; ++e) v[e] *= QS_NA;
                    }
                    o.x = pk2(v[0], v[1]); o.y = pk2(v[2], v[3]); o.z = pk2(v[4], v[5]); o.w = pk2(v[6], v[7]);
                    if (pn <= 2) { *(u32x4*)(Z + row * 768 + pn * 256 + cb) = o; }
                    else if (pn == 3) { const int head = bj * 4 + wc;
                        bf16_t* dst = DQ + ((size_t)(b * 8 + head) * NKEY + key) * 32;
                        *(u32x4*)(dst + 8 * fq) = o; }
                    else if (pn == 4) { const int head = bj * 4 + wc, vh = head >> 1, sub = head & 1;
                        unsigned char* dst = (unsigned char*)KV + ((size_t)(b * 4 + vh) * NCHUNK + chunk) * 8192 + sub * 2048 + (((fq >> 1) * 64) + kk + 32 * (fq & 1)) * 16;
                        *(u32x4*)dst = o; }
                    else if (pn == 5 || pn == 8) { const int head = bj * 2 + (wc >> 1), mt = wc & 1;
                        const int s = kk >> 4, hk = (kk >> 2) & 1, ee = ((kk >> 3) & 1) * 4 + (kk & 3);
                        unsigned char* base = (unsigned char*)KV + (pn == 5 ? 0 : NKV_BYTES) + ((size_t)(b * 4 + head) * NCHUNK + chunk) * 8192 + 4096 + ((mt * 2 + s) * 64 + 32 * hk + 8 * fq) * 16 + ee * 2;
                        const unsigned w4[4] = {o.x, o.y, o.z, o.w};
#pragma unroll
                        for (int e = 0; e < 8; ++e) *(bf16_t*)(base + e * 16) = (bf16_t)((e & 1) ? (w4[e >> 1] >> 16) : (w4[e >> 1] & 0xffffu)); }
                    else if (pn == 6) { const int head = bj * 2 + (wc >> 1);
                        bf16_t* dst = NQ + ((size_t)(b * 4 + head) * NKEY + key) * 64;
                        *(u32x4*)(dst + 32 * (wc & 1) + 8 * fq) = o; }
                    else { const int head = bj * 2 + (wc >> 1);
                        unsigned char* dst = (unsigned char*)KV + NKV_BYTES + ((size_t)(b * 4 + head) * NCHUNK + chunk) * 8192 + ((2 * (wc & 1) + (fq >> 1)) * 64 + kk + 32 * (fq & 1)) * 16;
                        *(u32x4*)dst = o; }
                }
            }
    }
};
#define MFMA32(a, b, c) __builtin_amdgcn_mfma_f32_32x32x16_bf16((a), (b), (c), 0, 0, 0)
template <int S> __device__ __forceinline__ bf16x8 pack_step(const f32x16& x) {
    u32x4 q; q.x = pk2(x[8 * S], x[8 * S + 1]); q.y = pk2(x[8 * S + 2], x[8 * S + 3]); q.z = pk2(x[8 * S + 4], x[8 * S + 5]); q.w = pk2(x[8 * S + 6], x[8 * S + 7]);
    return __builtin_bit_cast(bf16x8, q);
}
__device__ __forceinline__ float max16(const f32x16& s) {
    float a = fmaxf(fmaxf(s[0], s[1]), fmaxf(s[2], s[3])), b = fmaxf(fmaxf(s[4], s[5]), fmaxf(s[6], s[7]));
    float c = fmaxf(fmaxf(s[8], s[9]), fmaxf(s[10], s[11])), d = fmaxf(fmaxf(s[12], s[13]), fmaxf(s[14], s[15]));
    return fmaxf(fmaxf(a, b), fmaxf(c, d));
}
__device__ __forceinline__ float softmax_step(f32x16& s, float& m, float& l) {
    float mx = max16(s); mx = fmaxf(mx, __shfl_xor(mx, 32));
    const float mn = fmaxf(m, mx); const float alpha = ex2(m - mn); m = mn;
    float rs = 0.f;
#pragma unroll
    for (int i = 0; i < 16; ++i) { s[i] = ex2(s[i] - mn); rs += s[i]; }
    l = l * alpha + rs;
    return alpha;
}

__device__ __forceinline__ void diff_attn_unit(const Params& p, int l, LAS unsigned char* lds, int b, int vh, const bf16_t* Q0, const bf16_t* Q1, int q0,
                                               int tile_lo, int tile_hi, size_t out_row0, float lam, float post_scale) {
    const int tid = tid_now(), w = tid >> 6, lane = tid & 63, r = lane & 31, h = lane >> 5;
    bf16x8 qf[2][2];
#pragma unroll
    for (int ks = 0; ks < 2; ++ks) { qf[0][ks] = *(const bf16x8*)(Q0 + (size_t)(q0 + w * 32 + r) * 32 + ks * 16 + h * 8); qf[1][ks] = *(const bf16x8*)(Q1 + (size_t)(q0 + w * 32 + r) * 32 + ks * 16 + h * 8); }
    f32x16 O[2][2];
#pragma unroll
    for (int a = 0; a < 2; ++a)
#pragma unroll
        for (int c = 0; c < 2; ++c)
#pragma unroll
            for (int i = 0; i < 16; ++i) O[a][c][i] = 0.f;
    float mm[2] = {-3.0e38f, -3.0e38f}, ll[2] = {0.f, 0.f};
    const unsigned char* kv = (const unsigned char*)p.KV + (size_t)(b * 4 + vh) * NCHUNK * 8192;
    u32x4 r0 = *(const u32x4*)(kv + (size_t)tile_lo * 16384 + tid * 16), r1 = *(const u32x4*)(kv + (size_t)tile_lo * 16384 + 8192 + tid * 16);
    *(LAS u32x4*)(lds + tid * 16) = r0; *(LAS u32x4*)(lds + 8192 + tid * 16) = r1;
    __syncthreads();
    int cur = 0;
    for (int t = tile_lo; t < tile_hi; ++t) {
        const bool more = t + 1 < tile_hi;
        if (more) { r0 = *(const u32x4*)(kv + (size_t)(t + 1) * 16384 + tid * 16); r1 = *(const u32x4*)(kv + (size_t)(t + 1) * 16384 + 8192 + tid * 16); }
        LAS unsigned char* buf = lds + cur * 16384;
#pragma unroll
        for (int c = 0; c < 2; ++c) {
            LAS unsigned char* cb = buf + c * 8192;
            bf16x8 vf[2][2];
#pragma unroll
            for (int mt = 0; mt < 2; ++mt)
#pragma unroll
                for (int s = 0; s < 2; ++s) vf[mt][s] = *(const LAS bf16x8*)(cb + 4096 + ((mt * 2 + s) * 64 + lane) * 16);
#pragma unroll
            for (int sub = 0; sub < 2; ++sub) {
                const bf16x8 k0 = *(const LAS bf16x8*)(cb + sub * 2048 + lane * 16), k1 = *(const LAS bf16x8*)(cb + sub * 2048 + 1024 + lane * 16);
                f32x16 s;
#pragma unroll
                for (int i = 0; i < 16; ++i) s[i] = 0.f;
                s = MFMA32(k0, qf[sub][0], s); s = MFMA32(k1, qf[sub][1], s);
                const float alpha = softmax_step(s, mm[sub], ll[sub]);
#pragma unroll
                for (int mt = 0; mt < 2; ++mt)
#pragma unroll
                    for (int i = 0; i < 16; ++i) O[sub][mt][i] *= alpha;
                const bf16x8 p0 = pack_step<0>(s), p1 = pack_step<1>(s);
#pragma unroll
                for (int mt = 0; mt < 2; ++mt) { O[sub][mt] = MFMA32(vf[mt][0], p0, O[sub][mt]); O[sub][mt] = MFMA32(vf[mt][1], p1, O[sub][mt]); }
            }
        }
        if (more) { *(LAS u32x4*)(lds + (cur ^ 1) * 16384 + tid * 16) = r0; *(LAS u32x4*)(lds + (cur ^ 1) * 16384 + 8192 + tid * 16) = r1; }
        __syncthreads();
        cur ^= 1;
    }
    const float l0 = ll[0] + __shfl_xor(ll[0], 32), l1 = ll[1] + __shfl_xor(ll[1], 32);
    const float i0 = 1.0f / l0, i1 = lam / l1;
    float ss = 0.f;
#pragma unroll
    for (int mt = 0; mt < 2; ++mt)
#pragma unroll
        for (int i = 0; i < 16; ++i) { const float o = O[0][mt][i] * i0 - O[1][mt][i] * i1; O[0][mt][i] = o; ss += o * o; }
    ss += __shfl_xor(ss, 32);
    const float rr = rsqrtf(ss * (1.0f / 64.0f) + 1e-6f) * post_scale;
    const float* sg = p.diff_subln_g + l * 64;
    bf16_t* orow = p.MIX + (out_row0 + w * 32 + r) * D + 512 + vh * 64;
#pragma unroll
    for (int mt = 0; mt < 2; ++mt)
#pragma unroll
        for (int g4 = 0; g4 < 4; ++g4) { const int dv = 32 * mt + 8 * g4 + 4 * h; const f32x4 gg = *(const f32x4*)(sg + dv);
            u32x2 o; o.x = pk2(O[0][mt][4 * g4] * rr * gg.x, O[0][mt][4 * g4 + 1] * rr * gg.y); o.y = pk2(O[0][mt][4 * g4 + 2] * rr * gg.z, O[0][mt][4 * g4 + 3] * rr * gg.w);
            *(u32x2*)(orow + dv) = o; }
}

__device__ __forceinline__ void na_attn_wave(const bf16_t* qrow, const unsigned char* kvb, bool local, int r, int r0, int qcol, const LAS float* rpbh, bf16_t* orow) {
    const int lane = tid_now() & 63, h = lane >> 5;
    bf16x8 qf[4];
#pragma unroll
    for (int ks = 0; ks < 4; ++ks) qf[ks] = *(const bf16x8*)(qrow + ks * 16 + h * 8);
    f32x16 O[2];
#pragma unroll
    for (int c = 0; c < 2; ++c)
#pragma unroll
        for (int i = 0; i < 16; ++i) O[c][i] = 0.f;
    float m = -3.0e38f, l = 0.f;
    const int nch = local ? 24 : 8;
    const int c0 = min(max(qcol - 8, 0), 48);
    bf16x8 kf[4], vf[4];
    { const unsigned char* cp = kvb + (size_t)256 * 8192 + lane * 16;
#pragma unroll
      for (int q = 0; q < 4; ++q) { kf[q] = *(const bf16x8*)(cp + q * 1024); vf[q] = *(const bf16x8*)(cp + 4096 + q * 1024); } }
    for (int i = 0; i < nch; ++i) {
        bf16x8 nk[4], nv[4];
        { const int in = i + 1 < nch ? i + 1 : i; const int ch = in < 8 ? 256 + in : 2 * r0 + (in - 8);
          const unsigned char* cp = kvb + (size_t)ch * 8192 + lane * 16;
#pragma unroll
          for (int q = 0; q < 4; ++q) { nk[q] = *(const bf16x8*)(cp + q * 1024); nv[q] = *(const bf16x8*)(cp + 4096 + q * 1024); } }
        f32x16 s;
#pragma unroll
        for (int q = 0; q < 16; ++q) s[q] = 0.f;
#pragma unroll
        for (int ks = 0; ks < 4; ++ks) s = MFMA32(kf[ks], qf[ks], s);
        if (i >= 8) {
            const int jl = (i - 8) >> 1, kc0 = ((i - 8) & 1) * 32; const int dr = r0 + jl - r + 7; const LAS float* rp = rpbh + dr * 31;
#pragma unroll
            for (int q = 0; q < 16; ++q) { const int keycol = kc0 + (q & 3) + 8 * (q >> 2) + 4 * h; const bool valid = keycol >= c0 && keycol < c0 + 16;
                const int dc = valid ? keycol - qcol + 15 : 15; const float bias = rp[dc]; s[q] = valid ? s[q] + bias : -1.0e30f; }
        }
        const float alpha = softmax_step(s, m, l);
#pragma unroll
        for (int mt = 0; mt < 2; ++mt)
#pragma unroll
            for (int q = 0; q < 16; ++q) O[mt][q] *= alpha;
        const bf16x8 p0 = pack_step<0>(s), p1 = pack_step<1>(s);
        O[0] = MFMA32(vf[0], p0, O[0]); O[0] = MFMA32(vf[1], p1, O[0]); O[1] = MFMA32(vf[2], p0, O[1]); O[1] = MFMA32(vf[3], p1, O[1]);
#pragma unroll
        for (int q = 0; q < 4; ++q) { kf[q] = nk[q]; vf[q] = nv[q]; }
    }
    const float lt = l + __shfl_xor(l, 32); const float il = 1.0f / lt;
#pragma unroll
    for (int mt = 0; mt < 2; ++mt)
#pragma unroll
        for (int g4 = 0; g4 < 4; ++g4) { const int dv = 32 * mt + 8 * g4 + 4 * h;
            u32x2 o; o.x = pk2(O[mt][4 * g4] * il, O[mt][4 * g4 + 1] * il); o.y = pk2(O[mt][4 * g4 + 2] * il, O[mt][4 * g4 + 3] * il);
            *(u32x2*)(orow + dv) = o; }
}

__device__ __forceinline__ void seq_of_row(int row0, int& n, int& p0, size_t& seqbase) {
    if (row0 < NL) { n = SEQ; seqbase = (size_t)(row0 >> 13) << 13; p0 = row0 & (SEQ - 1); }
    else { const int rc = row0 - NL; n = CTXL; seqbase = (size_t)NL + ((rc >> 8) << 8); p0 = rc & (CTXL - 1); }
}
__device__ __forceinline__ void conv_item(const Params& p, int l, int it, LAS unsigned char* lds) {
    const int tid = tid_now(); const int row0 = it * 32; int n, p0; size_t seqbase; seq_of_row(row0, n, p0, seqbase);
    LAS float* glu = (LAS float*)lds; LAS float* hb = (LAS float*)(lds + 65536);
    const int c = tid & 255, th = tid >> 8;
    for (int rr = th; rr < 62; rr += 2) { const int pp = p0 - 15 + rr; float v = 0.f;
        if (pp >= 0 && pp < n) { const bf16_t* z = p.Z + (seqbase + pp) * 768 + 256; const float a = bf2f(z[c]), g = bf2f(z[256 + c]); v = a * fast_sigmoid(g); }
        glu[rr * 256 + c] = v; }
    __syncthreads();
    float wgt[31];
#pragma unroll
    for (int k = 0; k < 31; ++k) wgt[k] = p.conv_dw[(size_t)(l * 31 + k) * 256 + c];
    const float bias = p.conv_dw_b[l * 256 + c];
#pragma unroll 2
    for (int tt = 0; tt < 16; ++tt) { const int t = th * 16 + tt; float acc = bias;
#pragma unroll
        for (int k = 0; k < 31; ++k) acc += glu[(t + k) * 256 + c] * wgt[k];
        hb[t * 256 + c] = acc; }
    __syncthreads();
    const int w8 = tid >> 6, lane = tid & 63;
    const f32x4 lg = *(const f32x4*)(p.conv_ln_g + l * 256 + lane * 4), lb = *(const f32x4*)(p.conv_ln_b + l * 256 + lane * 4);
#pragma unroll
    for (int q = 0; q < 4; ++q) { const int t = w8 * 4 + q; const f32x4 v = *(const LAS f32x4*)(hb + t * 256 + lane * 4);
        const float mean = wave_sum(v.x + v.y + v.z + v.w) * (1.0f / 256.0f); const f32x4 d = v - mean;
        const float var = wave_sum(d.x * d.x + d.y * d.y + d.z * d.z + d.w * d.w) * (1.0f / 256.0f); const float rs = rsqrtf(var + 1e-5f);
        f32x4 y = d * rs * lg + lb; y.x *= fast_sigmoid(y.x); y.y *= fast_sigmoid(y.y); y.z *= fast_sigmoid(y.z); y.w *= fast_sigmoid(y.w);
        u32x2 o; o.x = pk2(y.x, y.y); o.y = pk2(y.z, y.w); *(u32x2*)(p.MIX + (size_t)(row0 + t) * D + 256 + lane * 4) = o; }
    __syncthreads();
}
__device__ __forceinline__ void pool_item(const Params& p, int it) {
    const int tid = tid_now(); const int row0 = it * 64; int n, p0; size_t seqbase; seq_of_row(row0, n, p0, seqbase);
    const int c2 = tid & 127, tq = tid >> 7; const int hw = 1 << (c2 >> 5);
    for (int tt = 0; tt < 16; ++tt) { const int pp = p0 + tq * 16 + tt; const int lo = max(pp - hw, 0), hi = min(pp + hw, n); float s0 = 0.f, s1 = 0.f;
        for (int q = lo; q < hi; ++q) { const unsigned u = *(const unsigned*)(p.Z + (seqbase + q) * 768 + 2 * c2); s0 += bflo(u); s1 += bfhi(u); }
        const float inv = 1.0f / (float)(hi - lo); const unsigned us = *(const unsigned*)(p.Z + (seqbase + pp) * 768 + 2 * c2);
        *(unsigned*)(p.MIX + (seqbase + pp) * D + 2 * c2) = pk2(s0 * inv - bflo(us), s1 * inv - bfhi(us)); }
}

__device__ __forceinline__ void mixers_phase(const Params& p, int l, LAS unsigned char* lds) {
    const int tid = tid_now(), bid = blockIdx.x, G = gridDim.x, w = tid >> 6, lane = tid & 63;
    const bool need_ctx = (l == 0);
    float lam, lam_init = l == 0 ? 0.2f : (0.8f - 0.6f * 0.7408182206817179f);
    { const float* lp = p.diff_lambda + l * 128; float s01 = 0.f, s23 = 0.f;
      for (int i = 0; i < 32; ++i) { s01 += lp[i] * lp[32 + i]; s23 += lp[64 + i] * lp[96 + i]; }
      lam = expf(s01) - expf(s23) + lam_init; }
    LAS float* rpbL = (LAS float*)(lds + 122880);
    for (int i = tid; i < 4 * 465; i += 512) rpbL[i] = p.na_rpb[(size_t)l * 4 * 465 + i] * LOG2E;
    __syncthreads();
    const int nun = need_ctx ? 264 : 256;
    for (int u = bid; u < nun; u += G) {
        int b, vh, q0, tlo; const bf16_t *Q0, *Q1; size_t orow;
        if (u < 256) { b = u >> 7; vh = (u >> 5) & 3; q0 = (u & 31) * 256; tlo = 0; orow = (size_t)b * SEQ + q0; }
        else { const int uu = u - 256; b = uu >> 2; vh = uu & 3; q0 = SEQ; tlo = 128; orow = (size_t)NL + b * CTXL; }
        Q0 = p.DQ + (size_t)(b * 8 + 2 * vh) * NKEY * 32; Q1 = Q0 + (size_t)NKEY * 32;
        diff_attn_unit(p, l, lds, b, vh, Q0, Q1, q0, tlo, 132, orow, lam, 1.0f - lam_init);
    }
    for (int u = bid; u < nun; u += G) {
        int b, head, r, r0, qcol; bool local; const bf16_t* qrow; bf16_t* orow; size_t qtok;
        if (u < 256) { b = u >> 7; r = u & 127; head = w >> 1; r0 = min(max(r - 4, 0), 120); qcol = (w & 1) * 32 + (lane & 31); local = true; const size_t tok = (size_t)r * 64 + qcol;
            qtok = tok; orow = p.MIX + ((size_t)b * SEQ + tok) * D + 768 + head * 64; }
        else { const int uu = u - 256; b = uu >> 2; head = uu & 3; r = 0; r0 = 0; qcol = 0; local = false; const int q = w * 32 + (lane & 31);
            qtok = SEQ + q; orow = p.MIX + ((size_t)NL + b * CTXL + q) * D + 768 + head * 64; }
        qrow = p.NQ + ((size_t)(b * 4 + head) * NKEY + qtok) * 64;
        na_attn_wave(qrow, (const unsigned char*)p.KV + NKV_BYTES + (size_t)(b * 4 + head) * NCHUNK * 8192, local, r, r0, qcol, rpbL + head * 465, orow);
    }
    __syncthreads();
    const int nconv = need_ctx ? NT / 32 : NL / 32, npool = need_ctx ? NT / 64 : NL / 64;
    for (int it = bid; it < nconv; it += G) conv_item(p, l, it, lds);
    for (int it = bid; it < npool; it += G) pool_item(p, it);
}
template <class T> __device__ __forceinline__ T* lds_ptr(const LAS unsigned* pl, int idx) {
    const unsigned lo = __builtin_amdgcn_readfirstlane(pl[2 * idx]), hi = __builtin_amdgcn_readfirstlane(pl[2 * idx + 1]);
    return (T*)(((unsigned long long)hi << 32) | lo);
}
#define LP(f) p.f = lds_ptr<std::remove_pointer<decltype(p.f)>::type>(pl, (int)(offsetof(Params, f) / 8));
__device__ __forceinline__ void run_phase(const LAS unsigned* pl, int ph, LAS unsigned char* lds) {
    const int bid = blockIdx.x, G = gridDim.x; Params p;
    if (ph == 0) { LP(c) LP(c_ctx) LP(w_mod) LP(b_mod) LP(ffn_in) LP(ffn_out) LP(w_in) LP(w_out) LP(pool_w) LP(pool_scale) LP(conv_pw) LP(conv_pw_b) LP(WTfi) LP(WTfo) LP(WTin) LP(WTout) LP(MOD) LP(ROPE) LP(ZBIAS)
        prep_phase(p, lds); return; }
    if (ph == 21) { LP(X) LP(g_final) LP(out) final_phase(p); return; }
    const int l = (ph - 1) / 10, s = (ph - 1) % 10; const int Mx = (l == 0) ? NT : NL;
    switch (s) {
    case 0: case 3: case 7: { LP(g_norm) LP(x) LP(ctx) LP(X) LP(MOD) LP(Y)
        norm_phase(p, l, s == 0 ? 0 : s == 3 ? 1 : 2, s == 7 ? 6 : s, s == 7 ? Mx : NT, l == 0 && s == 0); } break;
    case 1: case 8: { LP(Y) LP(WTfi) LP(H) const int f = s == 1 ? 0 : 1; Gemm g; g.A = p.Y; g.Bt = p.WTfi + (size_t)(l * 2 + f) * 2 * DFF * D; g.M = s == 1 ? NT : Mx; g.N = 2 * DFF; g.K = D; g.lda = D; g.ldb = D; g.apn = 0;
        pg8::StaticOrder S; S.init(g.M, g.N, G, bid); EpiSwiglu E; E.H = p.H;
        pg8::gemm_phase<EpiSwiglu, pg8::StaticOrder, true, true>(lds, g, S, E); } break;
    case 2: case 6: case 9: { LP(ZBIAS) LP(MIX) LP(WTout) LP(H) LP(WTfo) LP(X) LP(x) LP(ctx) LP(MOD) Gemm g; EpiResid E; E.X = p.X; E.xl = p.x; E.xc = p.ctx; E.first = (l == 0 && s == 2) ? 1 : 0;
        E.bo = p.ZBIAS + (s == 6 ? l : 2) * D;
        if (s == 6) { g.A = p.MIX; g.Bt = p.WTout + (size_t)l * D * D; g.M = Mx; g.K = D; g.lda = D; g.ldb = D; g.apn = 0; E.mod = p.MOD + (size_t)l * 3 * NMOD * D + 5 * D; E.coef = 1.0f; }
        else { const int f = s == 2 ? 0 : 1; g.A = p.H; g.Bt = p.WTfo + (size_t)(l * 2 + f) * D * DFF; g.M = s == 2 ? NT : Mx; g.K = DFF; g.lda = DFF; g.ldb = DFF; g.apn = 0;
               E.mod = p.MOD + (size_t)l * 3 * NMOD * D + (s == 2 ? 2 : 8) * D; E.coef = 0.5f; }
        g.N = D; pg8::StaticOrder S; S.init(g.M, g.N, G, bid);
        pg8::gemm_phase<EpiResid, pg8::StaticOrder, true, true>(lds, g, S, E); } break;
#ifndef SKIP_Z
    case 4: { LP(Y) LP(WTin) LP(Z) LP(DQ) LP(NQ) LP(KV) LP(ROPE) Gemm g; g.A = p.Y; g.Bt = p.WTin + (size_t)l * DIN * D; g.M = NT; g.N = DIN; g.K = D; g.lda = D; g.ldb = D; g.apn = 0;
        pg8::StaticOrder S; S.init(g.M, g.N, G, bid);
        EpiZ E; E.Z = p.Z; E.DQ = p.DQ; E.NQ = p.NQ; E.KV = p.KV; E.rope = p.ROPE;
        pg8::gemm_phase<EpiZ, pg8::StaticOrder, true, true>(lds, g, S, E); } break;
#endif
#ifndef SKIP_MIX
    case 5: { LP(diff_lambda) LP(na_rpb) LP(DQ) LP(NQ) LP(KV) LP(MIX) LP(diff_subln_g) LP(Z) LP(conv_dw) LP(conv_dw_b) LP(conv_ln_g) LP(conv_ln_b)
        mixers_phase(p, l, lds); } break;
#endif
    default: break;
    }
}

struct RawParams { unsigned w[sizeof(Params) / 4]; };
__global__ void __launch_bounds__(512) mega_fwd(const Params p) {
    extern __shared__ __attribute__((aligned(16))) unsigned char smem[];
    LAS unsigned char* lds = (LAS unsigned char*)smem;
    LAS unsigned* pl = (LAS unsigned*)(lds + 131072);
    { const RawParams raw = __builtin_bit_cast(RawParams, p);
#pragma unroll
      for (int i = 0; i < (int)(sizeof(Params) / 4); ++i) pl[i] = raw.w[i]; }
    __syncthreads();
    cg::grid_group grid = cg::this_grid();
    const int ph_lo = p.ph_lo, ph_hi = p.ph_hi;
    for (int ph = ph_lo; ph < ph_hi; ++ph) {
        run_phase(pl, ph, lds);
        if (ph + 1 < ph_hi) grid.sync();
    }
}

extern "C" void kernel_launch(void* const* d_in, const int* in_sizes, int n_in, void* d_out, int out_size, void* d_ws, size_t ws_size, hipStream_t stream) {
    static int grid_blocks = 0;
    if (!grid_blocks) {
        int dev = 0, cus = 0, per_cu = 0;
        (void)hipGetDevice(&dev);
        (void)hipDeviceGetAttribute(&cus, hipDeviceAttributeMultiprocessorCount, dev);
        if (hipFuncSetAttribute((const void*)mega_fwd, hipFuncAttributeMaxDynamicSharedMemorySize, LDS_ALLOC) != hipSuccess) fprintf(stderr, "hipFuncSetAttribute failed\n");
        if (hipOccupancyMaxActiveBlocksPerMultiprocessor(&per_cu, (const void*)mega_fwd, 512, LDS_ALLOC) != hipSuccess || per_cu < 1) { fprintf(stderr, "occupancy query: %d\n", per_cu); per_cu = 1; }
        (void)hipGetLastError();
        grid_blocks = cus * per_cu;
    }
    Params p{};
    const float** ins = (const float**)&p;
    for (int i = 0; i < 23; ++i) ins[i] = (const float*)d_in[i];
    p.out = (float*)d_out;
    size_t off = 0;
    auto take = [&](size_t bytes) { void* r = (char*)d_ws + off; off += (bytes + 255) & ~(size_t)255; return r; };
    p.WTfi = (bf16_t*)take((size_t)4 * 2 * DFF * D * 2); p.WTfo = (bf16_t*)take((size_t)4 * D * DFF * 2); p.WTin = (bf16_t*)take((size_t)2 * DIN * D * 2);
    p.WTout = (bf16_t*)take((size_t)2 * D * D * 2);
    p.MOD = (float*)take((size_t)2 * 3 * NMOD * D * 4); p.ROPE = (float*)take(2048 * 4); p.ZBIAS = (float*)take(3 * 1024 * 4); p.X = (float*)take((size_t)NT * D * 4); p.Y = (bf16_t*)take((size_t)NT * D * 2);
    const size_t reg0 = off;
    p.H = (bf16_t*)take((size_t)NT * DFF * 2);
    const size_t hend = off; off = reg0;
    p.Z = (bf16_t*)take((size_t)NT * 768 * 2); p.DQ = (bf16_t*)take((size_t)2 * 8 * NKEY * 32 * 2); p.NQ = (bf16_t*)take((size_t)2 * 4 * NKEY * 64 * 2); p.KV = (bf16_t*)take(2 * NKV_BYTES);
    p.MIX = (bf16_t*)take((size_t)NT * D * 2);
    if (off < hend) off = hend;
    if (off > ws_size) { fprintf(stderr, "workspace too small: need %zu have %zu\n", off, ws_size); return; }
#if MK_SPLIT
    for (int ph = 0; ph < 22; ++ph) { Params q = p; q.ph_lo = ph; q.ph_hi = ph + 1; void* args[] = {&q};
        hipError_t e = hipLaunchCooperativeKernel((const void*)mega_fwd, dim3(grid_blocks), dim3(512), args, LDS_ALLOC, stream);
        if (e != hipSuccess) fprintf(stderr, "launch failed: %s\n", hipGetErrorString(e)); }
#else
    p.ph_lo = 0; p.ph_hi = 22;
    void* args[] = {&p};
    hipError_t e = hipLaunchCooperativeKernel((const void*)mega_fwd, dim3(grid_blocks), dim3(512), args, LDS_ALLOC, stream);
    if (e != hipSuccess) fprintf(stderr, "cooperative launch failed: %s (grid %d)\n", hipGetErrorString(e), grid_blocks);
#endif
}
```

```cpp
#include <hip/hip_runtime.h>
#include <hip/hip_cooperative_groups.h>
#include <cstdio>
#include <cstdint>
#include <type_traits>
#include <cstddef>
namespace cg = cooperative_groups;
#ifndef MK_SPLIT
#define MK_SPLIT 0
#endif
__device__ __forceinline__ int tid_now() { int t = threadIdx.x; asm volatile("" : "+v"(t)); return t; }
namespace pg8 {
#define PG8_LAS __attribute__((address_space(3)))
typedef unsigned short bf16_t;
typedef short bf16x8 __attribute__((ext_vector_type(8)));
typedef float f32x4 __attribute__((ext_vector_type(4)));
typedef unsigned u32x4 __attribute__((ext_vector_type(4)));
constexpr int BM = 256, BK = 64, HALF = 128, HTB = HALF * BK * 2  , STAGE_BYTES = 8 * HTB, NXCD = 8, WGM = 8;

__host__ __device__ __forceinline__ int lds_byte(int r, int c) { const int st = (r >> 4) * 2 + (c >> 5), rr = r & 15, cc = c & 31, ob = rr * 64 + cc * 2; return st * 1024 + (ob ^ (((ob >> 9) & 1) << 5)); }
__host__ __device__ __forceinline__ void stage_rc(int b, int& R, int& C) { const int st = b / 1024, sb = b % 1024, swz = sb ^ (((sb >> 9) & 1) << 5); R = (st >> 1) * 16 + swz / 64; C = (st & 1) * 32 + (swz % 64) / 2; }
__host__ __device__ __forceinline__ int perm32(int rho) { const int n = rho >> 4, i = rho & 15; return 8 * (i >> 2) + 4 * n + (i & 3); }

struct Unit { int pm, pn; };
struct Gemm { const bf16_t* A; const bf16_t* Bt; int M, N, K, lda, ldb, apn; };

struct StaticOrder {
    int nM, nN, nwg, G, c;
    __host__ __device__ void init(int M, int N, int G_, int c_) { nM = M / BM; nN = N / BM; nwg = nM * nN; G = G_; c = c_; }
    __host__ __device__ bool next(int i, Unit& u) const {
        const long L = (long)i * G + c; if (L >= nwg) return false;
        int wgid = (int)L; { const int q = nwg / NXCD, r = nwg % NXCD, xcd = wgid % NXCD, off = wgid / NXCD; wgid = (xcd < r ? xcd * (q + 1) : r * (q + 1) + (xcd - r) * q) + off; }
        const int nig = WGM * nN, gid = wgid / nig, fm = gid * WGM, gsz = (nM - fm) < WGM ? (nM - fm) : WGM;
        u.pm = fm + ((wgid % nig) % gsz); u.pn = (wgid % nig) / gsz; return true;
    }
    __device__ __forceinline__ void a_ready(const Unit&) const {}
    __device__ __forceinline__ void done(const Unit&) const {}
};
template <class Epi, class Sched, bool ALIGN_EPI = false, bool SP2 = false>
__device__ __forceinline__ void gemm_phase(PG8_LAS unsigned char* lds, const Gemm g, const Sched& S, const Epi& E) {
    const int tid = tid_now(), wid = __builtin_amdgcn_readfirstlane(tid >> 6), lane = tid & 63, wr = wid >> 2, wc = wid & 3, fr = lane & 15, fq = lane >> 4;
    const int K = g.K, nt = K / BK;
    unsigned voffA[2], voffB[2];
#pragma unroll
    for (int i = 0; i < 2; ++i) { int R, C; stage_rc(tid * 16 + i * 8192, R, C); const int Rb = Epi::PERM ? ((R & ~31) + perm32(R & 31)) : R;
        voffA[i] = (unsigned)(R * g.lda + C) * 2u; voffB[i] = (unsigned)(Rb * g.ldb + C) * 2u; }
    const size_t kstep = (size_t)(BK * 2);
    const size_t hstepA = (size_t)HALF * g.lda * 2, hstepB = (size_t)HALF * g.ldb * 2;
    const size_t tstepA = 2 * hstepA, tstepB = 2 * hstepB;
    const unsigned ldsw = (unsigned)wid * 1024u;
    const int aoff = lds_byte(wr * 64 + fr, fq * 8), boff = lds_byte(wc * 32 + fr, fq * 8);
#define PG8_SA(b, h) (((b) * 2 + (h)) * HTB)
#define PG8_SB(b, h) ((4 + (b) * 2 + (h)) * HTB)
#define PG8_STAGE(bufoff, gbase, voff) do { _Pragma("unroll") for (int _i = 0; _i < 2; ++_i) \
        __builtin_amdgcn_global_load_lds((const unsigned*)((const char*)(gbase) + (voff)[_i]), (PG8_LAS unsigned*)(lds + (bufoff) + ldsw + _i * 8192), 16, 0, 0); } while (0)
#define PG8_LDA(dst, b, h) do { _Pragma("unroll") for (int m = 0; m < 4; ++m) _Pragma("unroll") for (int k = 0; k < 2; ++k) dst[m][k] = *(const PG8_LAS bf16x8*)(lds + PG8_SA(b, h) + aoff + m * 2048 + k * 1024); } while (0)
#define PG8_LDB(dst, b, h) do { _Pragma("unroll") for (int n = 0; n < 2; ++n) _Pragma("unroll") for (int k = 0; k < 2; ++k) dst[n][k] = *(const PG8_LAS bf16x8*)(lds + PG8_SB(b, h) + boff + n * 2048 + k * 1024); } while (0)
#define PG8_MMA(ai, bj, At, Bt) do { __builtin_amdgcn_s_setprio(1); _Pragma("unroll") for (int m = 0; m < 4; ++m) _Pragma("unroll") for (int n = 0; n < 2; ++n) _Pragma("unroll") for (int k = 0; k < 2; ++k) \
        acc[ai][bj][m][n] = __builtin_amdgcn_mfma_f32_16x16x32_bf16(Bt[n][k], At[m][k], acc[ai][bj][m][n], 0, 0, 0); __builtin_amdgcn_s_setprio(0); } while (0)
#define PG8_WAIT_V(n) asm volatile("s_waitcnt vmcnt(" #n ")" ::: "memory")
#define PG8_WAIT_L(n) asm volatile("s_waitcnt lgkmcnt(" #n ")" ::: "memory")
#define PG8_BAR __builtin_amdgcn_s_barrier()
#define PG8_SCHED __builtin_amdgcn_sched_barrier(0)
    Unit cur, nxt; int ui = 0;
    if (!S.next(0, cur)) return;
    f32x4 acc[2][2][4][2];
#pragma unroll
    for (int a = 0; a < 2; ++a)
#pragma unroll
        for (int b = 0; b < 2; ++b)
#pragma unroll
            for (int m = 0; m < 4; ++m)
#pragma unroll
                for (int n = 0; n < 2; ++n) acc[a][b][m][n] = (f32x4){0.f, 0.f, 0.f, 0.f};
    bf16x8 At[4][2], B0[2][2], B1[2][2];
    const char* cA = (const char*)g.A + (size_t)cur.pm * tstepA + (size_t)cur.pn * g.apn; const char* cB = (const char*)g.Bt + (size_t)cur.pn * tstepB;
    S.a_ready(cur);
    if constexpr (SP2) {
        PG8_STAGE(PG8_SB(0, 0), cB, voffB); PG8_STAGE(PG8_SB(0, 1), cB + hstepB, voffB); PG8_STAGE(PG8_SA(0, 0), cA, voffA); PG8_STAGE(PG8_SA(0, 1), cA + hstepA, voffA);
        if (wr == 1) PG8_BAR;
        PG8_WAIT_V(2); PG8_BAR;
        PG8_STAGE(PG8_SB(1, 0), cB + kstep, voffB); PG8_STAGE(PG8_SA(1, 0), cA + kstep, voffA); PG8_STAGE(PG8_SB(1, 1), cB + hstepB + kstep, voffB);
        PG8_WAIT_V(6); PG8_BAR;
    } else {
        PG8_STAGE(PG8_SB(0, 0), cB, voffB); PG8_STAGE(PG8_SA(0, 0), cA, voffA); PG8_STAGE(PG8_SB(0, 1), cB + hstepB, voffB); PG8_STAGE(PG8_SA(0, 1), cA + hstepA, voffA);
        if (wr == 1) PG8_BAR;
        PG8_WAIT_V(4); PG8_BAR;
        PG8_STAGE(PG8_SB(1, 0), cB + kstep, voffB); PG8_STAGE(PG8_SA(1, 0), cA + kstep, voffA); PG8_STAGE(PG8_SB(1, 1), cB + hstepB + kstep, voffB);
        PG8_WAIT_V(6); PG8_BAR;
    }
    for (;;) {
        const bool has_next = S.next(ui + 1, nxt);
        const char* nA = has_next ? (const char*)g.A + (size_t)nxt.pm * tstepA + (size_t)nxt.pn * g.apn : cA; const char* nB = has_next ? (const char*)g.Bt + (size_t)nxt.pn * tstepB : cB;
        for (int t = 0; t < nt; t += 2) {
            const bool last = (t == nt - 2);
            const char* a1 = cA + (size_t)(t + 1) * kstep;
            const char* a2 = last ? nA : cA + (size_t)(t + 2) * kstep; const char* b2 = last ? nB : cB + (size_t)(t + 2) * kstep;
            const char* a3 = a2 + kstep; const char* b3 = b2 + kstep;
            if (last && has_next) S.a_ready(nxt);
            if constexpr (SP2) {
            PG8_LDB(B0, 0, 0); PG8_LDB(B1, 0, 1); PG8_SCHED; PG8_LDA(At, 0, 0); PG8_STAGE(PG8_SA(1, 1), a1 + hstepA, voffA);
            PG8_WAIT_V(8); PG8_WAIT_L(0); PG8_BAR; PG8_MMA(0, 0, At, B0); PG8_MMA(0, 1, At, B1); PG8_BAR; PG8_SCHED;
            PG8_LDA(At, 0, 1); PG8_STAGE(PG8_SB(0, 0), b2, voffB); PG8_STAGE(PG8_SB(0, 1), b2 + hstepB, voffB); PG8_STAGE(PG8_SA(0, 0), a2, voffA);
            PG8_WAIT_V(8); PG8_WAIT_L(0); PG8_BAR; PG8_MMA(1, 0, At, B0); PG8_MMA(1, 1, At, B1); PG8_BAR; PG8_SCHED;
            PG8_LDB(B0, 1, 0); PG8_LDB(B1, 1, 1); PG8_SCHED; PG8_LDA(At, 1, 0); PG8_STAGE(PG8_SA(0, 1), a2 + hstepA, voffA);
            PG8_WAIT_V(8); PG8_WAIT_L(0); PG8_BAR; PG8_MMA(0, 0, At, B0); PG8_MMA(0, 1, At, B1); PG8_BAR; PG8_SCHED;
            PG8_LDA(At, 1, 1); PG8_STAGE(PG8_SB(1, 0), b3, voffB); PG8_STAGE(PG8_SB(1, 1), b3 + hstepB, voffB); PG8_STAGE(PG8_SA(1, 0), a3, voffA);
            PG8_WAIT_V(8); PG8_WAIT_L(0); PG8_BAR; PG8_MMA(1, 0, At, B0); PG8_MMA(1, 1, At, B1); PG8_BAR; PG8_SCHED;
            } else {
            PG8_LDB(B0, 0, 0); PG8_SCHED; PG8_LDA(At, 0, 0); PG8_STAGE(PG8_SA(1, 1), a1 + hstepA, voffA);
            PG8_WAIT_L(8); PG8_BAR; PG8_WAIT_L(0); PG8_MMA(0, 0, At, B0); PG8_BAR; PG8_SCHED;
            PG8_LDB(B1, 0, 1); PG8_STAGE(PG8_SB(0, 0), b2, voffB);
            PG8_BAR; PG8_WAIT_L(0); PG8_MMA(0, 1, At, B1); PG8_BAR;
            PG8_LDA(At, 0, 1); PG8_STAGE(PG8_SA(0, 0), a2, voffA);
            PG8_BAR; PG8_WAIT_L(0); PG8_MMA(1, 0, At, B0); PG8_BAR; PG8_SCHED;
            PG8_STAGE(PG8_SB(0, 1), b2 + hstepB, voffB);
            PG8_WAIT_V(6); PG8_BAR; PG8_MMA(1, 1, At, B1); PG8_BAR;
            PG8_LDB(B0, 1, 0); PG8_SCHED; PG8_LDA(At, 1, 0); PG8_STAGE(PG8_SA(0, 1), a2 + hstepA, voffA);
            PG8_WAIT_L(8); PG8_BAR; PG8_WAIT_L(0); PG8_MMA(0, 0, At, B0); PG8_BAR; PG8_SCHED;
            PG8_LDB(B1, 1, 1); PG8_STAGE(PG8_SB(1, 0), b3, voffB);
            PG8_BAR; PG8_WAIT_L(0); PG8_MMA(0, 1, At, B1); PG8_BAR;
            PG8_LDA(At, 1, 1); PG8_STAGE(PG8_SA(1, 0), a3, voffA);
            PG8_BAR; PG8_WAIT_L(0); PG8_MMA(1, 0, At, B0); PG8_BAR; PG8_SCHED;
            PG8_STAGE(PG8_SB(1, 1), b3 + hstepB, voffB);
            PG8_WAIT_V(6); PG8_BAR; PG8_MMA(1, 1, At, B1); PG8_BAR;
            }
        }
        if constexpr (ALIGN_EPI) { if (wr == 0) PG8_BAR; }
        if constexpr (!Epi::AFTER_DRAIN) { E(acc, cur, wr, wc, fr, fq); S.done(cur); }
        if (!has_next) break;
#pragma unroll
        for (int a = 0; a < 2; ++a)
#pragma unroll
            for (int b = 0; b < 2; ++b)
#pragma unroll
                for (int m = 0; m < 4; ++m)
#pragma unroll
                    for (int n = 0; n < 2; ++n) acc[a][b][m][n] = (f32x4){0.f, 0.f, 0.f, 0.f};
        cur = nxt; cA = nA; cB = nB; ++ui;
        if constexpr (ALIGN_EPI) { if (wr == 1) PG8_BAR; }
    }
    PG8_WAIT_V(0);
    if constexpr (!ALIGN_EPI) { if (wr == 0) PG8_BAR; }
    PG8_BAR;
    if constexpr (Epi::AFTER_DRAIN) { E.fused(acc, cur, wr, wc, fr, fq, lds, wid, lane); S.done(cur); }
#undef PG8_SA
#undef PG8_SB
#undef PG8_STAGE
#undef PG8_LDA
#undef PG8_LDB
#undef PG8_MMA
#undef PG8_WAIT_V
#undef PG8_WAIT_L
#undef PG8_BAR
#undef PG8_SCHED
}
}
#define LAS __attribute__((address_space(3)))
typedef unsigned short bf16_t;
typedef short bf16x8 __attribute__((ext_vector_type(8)));
typedef float f32x4 __attribute__((ext_vector_type(4)));
typedef float f32x2 __attribute__((ext_vector_type(2)));
typedef float f32x16 __attribute__((ext_vector_type(16)));
typedef unsigned u32x4 __attribute__((ext_vector_type(4)));
typedef unsigned u32x2 __attribute__((ext_vector_type(2)));
typedef __bf16 bf16x2_t __attribute__((ext_vector_type(2)));
using pg8::Unit; using pg8::Gemm;

constexpr int D = 1024, NL = 16384, NT = 16896, SEQ = 8192, CTXL = 256, DFF = 2816, DIN = 2304, NMOD = 9;
constexpr int NKEY = 8448;
constexpr size_t NKV_BYTES = (size_t)2 * 4 * 264 * 8192;
constexpr int NCHUNK = 264;
constexpr int LDS_BYTES = 131072, LDS_ALLOC = LDS_BYTES + 512;
constexpr float LOG2E = 1.4426950408889634f;
constexpr float QS_DIFF = 0.17677669529663687f * LOG2E;
constexpr float QS_NA = 0.125f * LOG2E;

struct Params {
    const float *x, *c, *ctx, *c_ctx, *w_mod, *b_mod, *g_norm, *ffn_in, *ffn_out, *w_in, *w_out, *pool_w, *pool_scale,
        *conv_dw, *conv_dw_b, *conv_ln_g, *conv_ln_b, *conv_pw, *conv_pw_b, *diff_lambda, *diff_subln_g, *na_rpb, *g_final;
    float* out;
    bf16_t *WTfi, *WTfo, *WTin, *WTout;
    float *MOD, *ROPE, *ZBIAS, *X, *PART, *BAR;
    bf16_t *Y, *H, *Z, *DQ, *NQ, *KV, *MIX;
    int ph_lo, ph_hi;
};

__device__ __forceinline__ unsigned pk2(float lo, float hi) { f32x2 v = {lo, hi}; bf16x2_t r = __builtin_convertvector(v, bf16x2_t); return __builtin_bit_cast(unsigned, r); }
__device__ __forceinline__ float bflo(unsigned u) { return __uint_as_float(u << 16); }
__device__ __forceinline__ float bfhi(unsigned u) { return __uint_as_float(u & 0xffff0000u); }
__device__ __forceinline__ float bf2f(bf16_t b) { return __uint_as_float((unsigned)b << 16); }
__device__ __forceinline__ float wave_sum(float v) {
#pragma unroll
    for (int o = 1; o < 64; o <<= 1) v += __shfl_xor(v, o);
    return v;
}
__device__ __forceinline__ float fast_sigmoid(float a) { return __builtin_amdgcn_rcpf(1.0f + __expf(-a)); }
__device__ __forceinline__ float ex2(float a) { return __builtin_amdgcn_exp2f(a); }

__device__ __forceinline__ void transpose_tile(const float* __restrict__ src, int N, int k0, int n0, bf16_t* dst, int drow0, int ldd, int dcol0, LAS float* tile, bool zero, const float* nscale = nullptr) {
    const int tid = tid_now();
#pragma unroll
    for (int i = 0; i < 8; ++i) { const int k = i * 8 + (tid >> 6), n = tid & 63; tile[k * 65 + n] = zero ? 0.f : src[(size_t)(k0 + k) * N + n0 + n]; }
    __syncthreads();
    { const int n = tid >> 3, kc = tid & 7; float v[8];
#pragma unroll
      for (int j = 0; j < 8; ++j) v[j] = tile[(kc * 8 + j) * 65 + n];
      if (nscale) { const float sc = nscale[n];
#pragma unroll
        for (int j = 0; j < 8; ++j) v[j] *= sc; }
      u32x4 o; o.x = pk2(v[0], v[1]); o.y = pk2(v[2], v[3]); o.z = pk2(v[4], v[5]); o.w = pk2(v[6], v[7]);
      *(u32x4*)(dst + (size_t)(drow0 + n) * ldd + dcol0 + kc * 8) = o; }
    __syncthreads();
}

__device__ __forceinline__ void transpose_wave(const float* __restrict__ src, int N, int k0, int n0, bf16_t* dst, int ldd, int lane, bool swiglu) {
    const int kg = lane & 7, ng = lane >> 3; f32x4 v[8];
    const float* s = src + (size_t)(k0 + kg * 8) * N + n0 + ng * 4;
#pragma unroll
    for (int j = 0; j < 8; ++j) v[j] = *(const f32x4*)(s + (size_t)j * N);
#pragma unroll
    for (int e = 0; e < 4; ++e) { const int n = n0 + ng * 4 + e; int drow = n;
        if (swiglu) { const int j0 = n < DFF ? n : n - DFF; drow = (j0 >> 7) * 256 + (n < DFF ? 0 : 128) + (j0 & 127); }
        u32x4 o; o.x = pk2(v[0][e], v[1][e]); o.y = pk2(v[2][e], v[3][e]); o.z = pk2(v[4][e], v[5][e]); o.w = pk2(v[6][e], v[7][e]);
        *(u32x4*)(dst + (size_t)drow * ldd + k0 + kg * 8) = o; }
}

__device__ __forceinline__ void prep_phase(const Params& p, LAS unsigned char* lds) {
    const int tid = tid_now(), bid = blockIdx.x, G = gridDim.x, lane = tid & 63;
    LAS float* tile = (LAS float*)lds;
    {
        constexpr int W_FI = 4 * 16 * 176, W_FO = 4 * 44 * 32, W_IN = 2 * 16 * 72, W_OUT = 2 * 8 * 32, W_ALL = W_FI + W_FO + W_IN + W_OUT;
#ifdef PROBE_TR2
        for (int rep = 0; rep < 2; ++rep)
#endif
        for (int it = bid * 8 + (tid >> 6); it < W_ALL; it += G * 8) {
            int r = it;
            if (r < W_FI) { const int mat = r / 2816, q = r % 2816, kb = q / 176, nb = q % 176;
                transpose_wave(p.ffn_in + (size_t)mat * D * 2 * DFF, 2 * DFF, kb * 64, nb * 32, p.WTfi + (size_t)mat * 2 * DFF * D, D, lane, true); continue; }
            r -= W_FI;
            if (r < W_FO) { const int mat = r / 1408, q = r % 1408, kb = q / 32, nb = q % 32;
                transpose_wave(p.ffn_out + (size_t)mat * DFF * D, D, kb * 64, nb * 32, p.WTfo + (size_t)mat * D * DFF, DFF, lane, false); continue; }
            r -= W_FO;
            if (r < W_IN) { const int mat = r / 1152, q = r % 1152, kb = q / 72, nb = q % 72;
                transpose_wave(p.w_in + (size_t)mat * D * DIN, DIN, kb * 64, nb * 32, p.WTin + (size_t)mat * DIN * D, D, lane, false); continue; }
            r -= W_IN;
            { const int mat = r / 256, q = r % 256, kb = 8 + q / 32, nb = q % 32;
                transpose_wave(p.w_out + (size_t)mat * D * D, D, kb * 64, nb * 32, p.WTout + (size_t)mat * D * D, D, lane, false); }
        }
    }
#ifdef PROBE_FOLD2
    for (int rep = 0; rep < 2; ++rep)
#endif
    for (int it = bid; it < 256; it += G) {
        {
            const int r = it; const int mat = r / 128, q = r % 128, kb = q / 16, nb = q % 16; const int n = tid & 63, kq = tid >> 6;
            const float* wo = p.w_out + (size_t)mat * D * D + nb * 64 + n; float acc[8];
#pragma unroll
            for (int i = 0; i < 8; ++i) acc[i] = 0.f;
            if (kb < 4) { const float* A = p.pool_w + (size_t)(mat * 4 + kb) * 4096 + (kq * 8) * 64; const float* ps = p.pool_scale + mat * 256 + kb * 64;
#pragma unroll 16
                for (int j = 0; j < 64; ++j) { const float wv = wo[(size_t)(kb * 64 + j) * D] * ps[j];
#pragma unroll
                    for (int i = 0; i < 8; ++i) acc[i] += A[i * 64 + j] * wv; } }
            else { const float* A = p.conv_pw + (size_t)mat * 65536 + (size_t)((kb - 4) * 64 + kq * 8) * 256;
#pragma unroll 16
                for (int j = 0; j < 256; ++j) { const float wv = wo[(size_t)(256 + j) * D];
#pragma unroll
                    for (int i = 0; i < 8; ++i) acc[i] += A[i * 256 + j] * wv; } }
#pragma unroll
            for (int i = 0; i < 8; ++i) tile[(kq * 8 + i) * 65 + n] = acc[i];
            __syncthreads();
            { const int n2 = tid >> 3, kc = tid & 7; float vv[8];
#pragma unroll
              for (int j = 0; j < 8; ++j) vv[j] = tile[(kc * 8 + j) * 65 + n2];
              u32x4 o; o.x = pk2(vv[0], vv[1]); o.y = pk2(vv[2], vv[3]); o.z = pk2(vv[4], vv[5]); o.w = pk2(vv[6], vv[7]);
              *(u32x4*)(p.WTout + (size_t)mat * D * D + (size_t)(nb * 64 + n2) * D + kb * 64 + kc * 8) = o; }
            __syncthreads();
        }
    }
    for (int it0 = bid; it0 < 48; it0 += G) { const int it = 47 - it0; const int mat = it / 16, nb = it % 16; const int n = tid & 63, jq = tid >> 6; float s = 0.f;
        if (mat < 2) { const float* wo = p.w_out + (size_t)mat * D * D + nb * 64 + n; const float* pb = p.conv_pw_b + mat * 256;
#pragma unroll 16
            for (int j = jq * 32; j < jq * 32 + 32; ++j) s += pb[j] * wo[(size_t)(256 + j) * D]; }
        tile[jq * 64 + n] = s;
        __syncthreads();
        if (tid < 64) { float t = 0.f;
#pragma unroll
            for (int q = 0; q < 8; ++q) t += tile[q * 64 + tid];
            p.ZBIAS[mat * D + nb * 64 + tid] = t; }
        __syncthreads(); }
    LAS float* sv = (LAS float*)(lds + 32768);
    LAS float* red = (LAS float*)(lds + 49152);
    for (int i = tid; i < 3072; i += 512) { const float a = i < 2048 ? p.c[i] : p.c_ctx[i - 2048]; sv[i] = a * fast_sigmoid(a); }
    __syncthreads();
#ifdef PROBE_MOD2
    for (int rep = 0; rep < 2; ++rep)
#endif
    for (int it0 = bid; it0 < 144; it0 += G) {
        const int it = 143 - it0;
        const int l = it / 72, n0 = (it % 72) * 128, ks = tid >> 6;
        const float* W = p.w_mod + (size_t)l * D * (NMOD * D) + n0 + lane * 2;
        f32x2 a0 = {0.f, 0.f}, a1 = {0.f, 0.f}, a2 = {0.f, 0.f};
#pragma unroll 16
        for (int k = ks * 128; k < ks * 128 + 128; ++k) { const f32x2 w = *(const f32x2*)(W + (size_t)k * (NMOD * D)); a0 += sv[k] * w; a1 += sv[1024 + k] * w; a2 += sv[2048 + k] * w; }
        LAS f32x2* red2 = (LAS f32x2*)red;
        red2[(ks * 3 + 0) * 64 + lane] = a0; red2[(ks * 3 + 1) * 64 + lane] = a1; red2[(ks * 3 + 2) * 64 + lane] = a2;
        __syncthreads();
        if (tid < 192) { const int vv = tid >> 6; f32x2 s = {0.f, 0.f};
#pragma unroll
            for (int q = 0; q < 8; ++q) s += red2[(q * 3 + vv) * 64 + lane];
            const f32x2 bb = *(const f32x2*)(p.b_mod + (size_t)l * (NMOD * D) + n0 + lane * 2);
            *(f32x2*)(p.MOD + (size_t)(l * 3 + vv) * (NMOD * D) + n0 + lane * 2) = s + bb; }
        __syncthreads();
    }
    if (bid == G - 1) {
        for (int idx = tid; idx < 1024; idx += 512) { const int pos = idx >> 3, i = idx & 7;
            const float inv = exp2f(-(float)i * (13.287712379549449f / 8.0f)); const float ang = (float)pos * inv;
            const float kf = rintf(ang * 0.15915494309189535f); float rr = fmaf(-kf, 6.2831855f, ang); rr = fmaf(-kf, -1.7484555e-7f, rr);
            p.ROPE[idx * 2] = __cosf(rr); p.ROPE[idx * 2 + 1] = __sinf(rr); }
    }
}

__device__ __forceinline__ void norm_phase(const Params& p, int l, int gi, int si, int M, bool first, int nkc, const float* fixg, const float* fixb) {
    const int tid = tid_now(), lane = tid & 63; const int NW = gridDim.x * 8;
    const float* g = p.g_norm + (size_t)(l * 3 + gi) * D;
    for (int row = blockIdx.x * 8 + (tid >> 6); row < M; row += NW) {
        const int vec = row < SEQ ? 0 : row < NL ? 1 : 2;
        const float* xr = first ? (row < NL ? p.x + (size_t)row * D : p.ctx + (size_t)(row - NL) * D) : p.X + (size_t)row * D;
        const float* sh = p.MOD + (size_t)(l * 3 + vec) * (NMOD * D) + si * D; const float* sc = sh + D;
        f32x4 v[4]; float ss = 0.f;
#pragma unroll
        for (int j = 0; j < 4; ++j) { v[j] = *(const f32x4*)(xr + j * 256 + lane * 4); ss += v[j].x * v[j].x + v[j].y * v[j].y + v[j].z * v[j].z + v[j].w * v[j].w; }
        if (row >= NL && (first || nkc > 0)) {
            ss = 0.f;
#pragma unroll
            for (int j = 0; j < 4; ++j) { if (fixb) v[j] += *(const f32x4*)(fixg + j * 256 + lane * 4) * *(const f32x4*)(fixb + j * 256 + lane * 4);
                for (int kc = 0; kc < nkc; ++kc) v[j] += *(const f32x4*)(p.PART + ((size_t)kc * 512 + (row - NL)) * D + j * 256 + lane * 4);
                *(f32x4*)(p.X + (size_t)row * D + j * 256 + lane * 4) = v[j]; ss += v[j].x * v[j].x + v[j].y * v[j].y + v[j].z * v[j].z + v[j].w * v[j].w; } }
        ss = wave_sum(ss); const float rs = rsqrtf(ss * (1.0f / D) + 1e-6f);
#pragma unroll
        for (int j = 0; j < 4; ++j) { const int col = j * 256 + lane * 4;
            const f32x4 gv = *(const f32x4*)(g + col), scv = *(const f32x4*)(sc + col), shv = *(const f32x4*)(sh + col);
            const f32x4 y = v[j] * rs * gv * (1.0f + scv) + shv;
            u32x2 o; o.x = pk2(y.x, y.y); o.y = pk2(y.z, y.w); *(u32x2*)(p.Y + (size_t)row * D + col) = o; }
    }
}
__device__ __forceinline__ void final_phase(const Params& p) {
    const int tid = tid_now(), lane = tid & 63; const int NW = gridDim.x * 8;
    for (int row = blockIdx.x * 8 + (tid >> 6); row < NL; row += NW) {
        const float* xr = p.X + (size_t)row * D; f32x4 v[4]; float ss = 0.f;
#pragma unroll
        for (int j = 0; j < 4; ++j) { v[j] = *(const f32x4*)(xr + j * 256 + lane * 4); ss += v[j].x * v[j].x + v[j].y * v[j].y + v[j].z * v[j].z + v[j].w * v[j].w; }
        ss = wave_sum(ss); const float rs = rsqrtf(ss * (1.0f / D) + 1e-6f);
#pragma unroll
        for (int j = 0; j < 4; ++j) { const int col = j * 256 + lane * 4; const f32x4 gv = *(const f32x4*)(p.g_final + col);
            *(f32x4*)(p.out + (size_t)row * D + col) = v[j] * rs * gv; }
    }
}
struct EpiSwiglu {
    static constexpr bool PERM = true, AFTER_DRAIN = false;
    bf16_t* H;
    __device__ __forceinline__ void operator()(const f32x4 (&acc)[2][2][4][2], const Unit& u, int wr_, int wc_, int fr_, int fq_) const {
        const int tq_ = tid_now(); const int wid_ = __builtin_amdgcn_readfirstlane(tq_ >> 6), wr = wid_ >> 2, wc = wid_ & 3, fr = tq_ & 15, fq = (tq_ & 63) >> 4;
        const int row0 = u.pm * 256 + wr * 64 + fr, col0 = u.pn * 128 + wc * 32 + 8 * fq;
#pragma unroll
        for (int ai = 0; ai < 2; ++ai)
#pragma unroll
            for (int m = 0; m < 4; ++m) { float h[8];
#pragma unroll
                for (int n = 0; n < 2; ++n)
#pragma unroll
                    for (int j = 0; j < 4; ++j) { const float a = acc[ai][0][m][n][j], g = acc[ai][1][m][n][j]; h[n * 4 + j] = a * fast_sigmoid(a) * g; }
                u32x4 o; o.x = pk2(h[0], h[1]); o.y = pk2(h[2], h[3]); o.z = pk2(h[4], h[5]); o.w = pk2(h[6], h[7]);
                *(u32x4*)(H + (size_t)(row0 + ai * 128 + m * 16) * DFF + col0) = o; }
    }
};
struct EpiResid {
    static constexpr bool PERM = false, AFTER_DRAIN = false;
    float* X; const float* xl; const float* mod; const float* bo; float coef; int first;
    __device__ __forceinline__ void operator()(const f32x4 (&acc)[2][2][4][2], const Unit& u, int wr_, int wc_, int fr_, int fq_) const {
        const int tq_ = tid_now(); const int wid_ = __builtin_amdgcn_readfirstlane(tq_ >> 6), wr = wid_ >> 2, wc = wid_ & 3, fr = tq_ & 15, fq = (tq_ & 63) >> 4;
        const int pm = u.pm; const int vec = pm < 32 ? 0 : pm < 64 ? 1 : 2;
        const float* gate = mod + (size_t)vec * (NMOD * D);
        const float* xin = first ? xl + (size_t)pm * 256 * D : X + (size_t)pm * 256 * D;
        float* xo = X + (size_t)pm * 256 * D;
        const int rl0 = wr * 64 + fr, col0 = u.pn * 256 + wc * 32 + 4 * fq;
#pragma unroll
        for (int bj = 0; bj < 2; ++bj)
#pragma unroll
            for (int n = 0; n < 2; ++n) { const int col = col0 + bj * 128 + n * 16; const f32x4 gv = *(const f32x4*)(gate + col) * coef; const f32x4 bv = *(const f32x4*)(bo + col);
#pragma unroll
                for (int ai = 0; ai < 2; ++ai)
#pragma unroll
                    for (int m = 0; m < 4; ++m) { const size_t off = (size_t)(rl0 + ai * 128 + m * 16) * D + col;
                        const f32x4 xv = *(const f32x4*)(xin + off); *(f32x4*)(xo + off) = xv + gv * (acc[ai][bj][m][n] + bv); } }
    }
};
struct EpiResidPartial {
    static constexpr bool PERM = false, AFTER_DRAIN = false;
    float* P; const float* gate; float coef;
    __device__ __forceinline__ void operator()(const f32x4 (&acc)[2][2][4][2], const Unit& u, int wr_, int wc_, int fr_, int fq_) const {
        const int tq_ = tid_now(); const int wid_ = __builtin_amdgcn_readfirstlane(tq_ >> 6), wr = wid_ >> 2, wc = wid_ & 3, fr = tq_ & 15, fq = (tq_ & 63) >> 4;
        float* xo = P + (size_t)u.pm * 256 * D + (size_t)(wr * 64 + fr) * D + u.pn * 256 + wc * 32 + 4 * fq;
        const float* gp = gate + u.pn * 256 + wc * 32 + 4 * fq;
#pragma unroll
        for (int bj = 0; bj < 2; ++bj)
#pragma unroll
            for (int n = 0; n < 2; ++n) { const f32x4 gv = *(const f32x4*)(gp + bj * 128 + n * 16) * coef;
#pragma unroll
                for (int ai = 0; ai < 2; ++ai)
#pragma unroll
                    for (int m = 0; m < 4; ++m) *(f32x4*)(xo + (size_t)(ai * 128 + m * 16) * D + bj * 128 + n * 16) = gv * acc[ai][bj][m][n]; }
    }
};
struct EpiZ {
    static constexpr bool PERM = true, AFTER_DRAIN = false;
    bf16_t *Z, *DQ, *NQ, *KV; const float* rope;
    __device__ __forceinline__ void operator()(const f32x4 (&acc)[2][2][4][2], const Unit& u, int wr_, int wc_, int fr_, int fq_) const {
        const int tq_ = tid_now(); const int wid_ = __builtin_amdgcn_readfirstlane(tq_ >> 6), wr = wid_ >> 2, wc = wid_ & 3, fr = tq_ & 15, fq = (tq_ & 63) >> 4;
        const int pn = u.pn, pm = u.pm; const bool isctx = pm >= 64; const int b = isctx ? pm - 64 : pm >> 5;
#pragma unroll
        for (int ai = 0; ai < 2; ++ai)
#pragma unroll
            for (int m = 0; m < 4; ++m) {
                const int rl = ai * 128 + wr * 64 + m * 16 + fr; const size_t row = (size_t)pm * 256 + rl;
                const int t = isctx ? rl : (pm & 31) * 256 + rl;
                const int key = isctx ? SEQ + rl : t;
                const int chunk = key >> 5, kk = key & 31;
#pragma unroll
                for (int bj = 0; bj < 2; ++bj) {
                    float v[8];
#pragma unroll
                    for (int e = 0; e < 8; ++e) v[e] = acc[ai][bj][m][e >> 2][e & 3];
                    const int cb = bj * 128 + wc * 32 + 8 * fq;
                    if (pn == 3 || pn == 4) {
                        const int pos = fq < 2 ? (t >> 6) : (t & 63); const float* rt = rope + pos * 16; const float sgn = (fq & 1) ? 1.0f : -1.0f;
#pragma unroll
                        for (int e = 0; e < 8; ++e) { const float pv = __shfl_xor(v[e], 16); if (!isctx) { const float cs = rt[2 * e], sn = rt[2 * e + 1]; v[e] = v[e] * cs + sgn * pv * sn; } }
                    }
                    u32x4 o;
                    if (pn == 3) {
#pragma unroll
                        for (int e = 0; e < 8; ++e) v[e] *= QS_DIFF;
                    } else if (pn == 6) {
#pragma unroll
                        for (int e = 0; e < 8; ++e) v[e] *= QS_NA;
                    }
                    o.x = pk2(v[0], v[1]); o.y = pk2(v[2], v[3]); o.z = pk2(v[4], v[5]); o.w = pk2(v[6], v[7]);
                    if (pn <= 2) { *(u32x4*)(Z + row * 768 + pn * 256 + cb) = o; }
                    else if (pn == 3) { const int head = bj * 4 + wc;
                        bf16_t* dst = DQ + ((size_t)(b * 8 + head) * NKEY + key) * 32;
                        *(u32x4*)(dst + 8 * fq) = o; }
                    else if (pn == 4) { const int head = bj * 4 + wc, vh = head >> 1, sub = head & 1;
                        unsigned char* dst = (unsigned char*)KV + ((size_t)(b * 4 + vh) * NCHUNK + chunk) * 8192 + sub * 2048 + (((fq >> 1) * 64) + kk + 32 * (fq & 1)) * 16;
                        *(u32x4*)dst = o; }
                    else if (pn == 5 || pn == 8) { const int head = bj * 2 + (wc >> 1), mt = wc & 1;
                        const int s = kk >> 4, hk = (kk >> 2) & 1, ee = ((kk >> 3) & 1) * 4 + (kk & 3);
                        unsigned char* base = (unsigned char*)KV + (pn == 5 ? 0 : NKV_BYTES) + ((size_t)(b * 4 + head) * NCHUNK + chunk) * 8192 + 4096 + ((mt * 2 + s) * 64 + 32 * hk + 8 * fq) * 16 + ee * 2;
                        const unsigned w4[4] = {o.x, o.y, o.z, o.w};
#pragma unroll
                        for (int e = 0; e < 8; ++e) *(bf16_t*)(base + e * 16) = (bf16_t)((e & 1) ? (w4[e >> 1] >> 16) : (w4[e >> 1] & 0xffffu)); }
                    else if (pn == 6) { const int head = bj * 2 + (wc >> 1);
                        bf16_t* dst = NQ + ((size_t)(b * 4 + head) * NKEY + key) * 64;
                        *(u32x4*)(dst + 32 * (wc & 1) + 8 * fq) = o; }
                    else { const int head = bj * 2 + (wc >> 1);
                        unsigned char* dst = (unsigned char*)KV + NKV_BYTES + ((size_t)(b * 4 + head) * NCHUNK + chunk) * 8192 + ((2 * (wc & 1) + (fq >> 1)) * 64 + kk + 32 * (fq & 1)) * 16;
                        *(u32x4*)dst = o; }
                }
            }
    }
};
#define MFMA32(a, b, c) __builtin_amdgcn_mfma_f32_32x32x16_bf16((a), (b), (c), 0, 0, 0)
template <int S> __device__ __forceinline__ bf16x8 pack_step(const f32x16& x) {
    u32x4 q; q.x = pk2(x[8 * S], x[8 * S + 1]); q.y = pk2(x[8 * S + 2], x[8 * S + 3]); q.z = pk2(x[8 * S + 4], x[8 * S + 5]); q.w = pk2(x[8 * S + 6], x[8 * S + 7]);
    return __builtin_bit_cast(bf16x8, q);
}
__device__ __forceinline__ float max16(const f32x16& s) {
    float a = fmaxf(fmaxf(s[0], s[1]), fmaxf(s[2], s[3])), b = fmaxf(fmaxf(s[4], s[5]), fmaxf(s[6], s[7]));
    float c = fmaxf(fmaxf(s[8], s[9]), fmaxf(s[10], s[11])), d = fmaxf(fmaxf(s[12], s[13]), fmaxf(s[14], s[15]));
    return fmaxf(fmaxf(a, b), fmaxf(c, d));
}
__device__ __forceinline__ float softmax_step(f32x16& s, float& m, float& l) {
    float mx = max16(s); mx = fmaxf(mx, __shfl_xor(mx, 32));
    const float mn = fmaxf(m, mx); const float alpha = ex2(m - mn); m = mn;
    float rs = 0.f;
#pragma unroll
    for (int i = 0; i < 16; ++i) { s[i] = ex2(s[i] - mn); rs += s[i]; }
    l = l * alpha + rs;
    return alpha;
}

__device__ __forceinline__ void diff_attn_unit(const Params& p, int l, LAS unsigned char* lds, int b, int vh, const bf16_t* Q0, const bf16_t* Q1, int q0,
                                               int tile_lo, int tile_hi, size_t out_row0, float lam, float post_scale) {
    const int tid = tid_now(), w = tid >> 6, lane = tid & 63, r = lane & 31, h = lane >> 5;
    bf16x8 qf[2][2];
#pragma unroll
    for (int ks = 0; ks < 2; ++ks) { qf[0][ks] = *(const bf16x8*)(Q0 + (size_t)(q0 + w * 32 + r) * 32 + ks * 16 + h * 8); qf[1][ks] = *(const bf16x8*)(Q1 + (size_t)(q0 + w * 32 + r) * 32 + ks * 16 + h * 8); }
    f32x16 O[2][2], negm[2];
#pragma unroll
    for (int a = 0; a < 2; ++a)
#pragma unroll
        for (int i = 0; i < 16; ++i) { O[a][0][i] = 0.f; O[a][1][i] = 0.f; negm[a][i] = 0.f; }
    float ll[2] = {0.f, 0.f};
    const unsigned char* kv = (const unsigned char*)p.KV + (size_t)(b * 4 + vh) * NCHUNK * 8192;
    u32x4 r0 = *(const u32x4*)(kv + (size_t)tile_lo * 16384 + tid * 16), r1 = *(const u32x4*)(kv + (size_t)tile_lo * 16384 + 8192 + tid * 16);
    *(LAS u32x4*)(lds + tid * 16) = r0; *(LAS u32x4*)(lds + 8192 + tid * 16) = r1;
    __syncthreads();
    int cur = 0;
    for (int t = tile_lo; t < tile_hi; ++t) {
        const bool more = t + 1 < tile_hi;
        if (more) { r0 = *(const u32x4*)(kv + (size_t)(t + 1) * 16384 + tid * 16); r1 = *(const u32x4*)(kv + (size_t)(t + 1) * 16384 + 8192 + tid * 16); }
        LAS unsigned char* buf = lds + cur * 16384;
#pragma unroll
        for (int c = 0; c < 2; ++c) {
            LAS unsigned char* cb = buf + c * 8192;
            const bool first = (t == tile_lo) && (c == 0);
            bf16x8 vf[2][2];
#pragma unroll
            for (int mt = 0; mt < 2; ++mt)
#pragma unroll
                for (int s = 0; s < 2; ++s) vf[mt][s] = *(const LAS bf16x8*)(cb + 4096 + ((mt * 2 + s) * 64 + lane) * 16);
#pragma unroll
            for (int sub = 0; sub < 2; ++sub) {
                const bf16x8 k0 = *(const LAS bf16x8*)(cb + sub * 2048 + lane * 16), k1 = *(const LAS bf16x8*)(cb + sub * 2048 + 1024 + lane * 16);
                f32x16 s = MFMA32(k0, qf[sub][0], negm[sub]); s = MFMA32(k1, qf[sub][1], s);
                f32x16 pr; float rs = 0.f;
#pragma unroll
                for (int i = 0; i < 16; ++i) { pr[i] = ex2(s[i]); rs += pr[i]; }
                const bool bad = first || !(rs < 4096.0f);
                if (__builtin_amdgcn_ballot_w64(bad) != 0ull) {
                    s = MFMA32(k0, qf[sub][0], negm[sub]); s = MFMA32(k1, qf[sub][1], s);
                    float mx = max16(s); mx = fmaxf(mx, __shfl_xor(mx, 32));
                    const float delta = first ? mx : fmaxf(mx, 0.f);
                    const float alpha = first ? 1.0f : ex2(-delta);
#pragma unroll
                    for (int mt = 0; mt < 2; ++mt)
#pragma unroll
                        for (int i = 0; i < 16; ++i) O[sub][mt][i] *= alpha;
                    ll[sub] *= alpha; rs = 0.f;
#pragma unroll
                    for (int i = 0; i < 16; ++i) { negm[sub][i] -= delta; pr[i] = ex2(s[i] - delta); rs += pr[i]; }
                }
                ll[sub] += rs;
                const bf16x8 p0 = pack_step<0>(pr), p1 = pack_step<1>(pr);
#pragma unroll
                for (int mt = 0; mt < 2; ++mt) { O[sub][mt] = MFMA32(vf[mt][0], p0, O[sub][mt]); O[sub][mt] = MFMA32(vf[mt][1], p1, O[sub][mt]); }
            }
        }
        if (more) { *(LAS u32x4*)(lds + (cur ^ 1) * 16384 + tid * 16) = r0; *(LAS u32x4*)(lds + (cur ^ 1) * 16384 + 8192 + tid * 16) = r1; }
        __syncthreads();
        cur ^= 1;
    }
    const float l0 = ll[0] + __shfl_xor(ll[0], 32), l1 = ll[1] + __shfl_xor(ll[1], 32);
    const float i0 = 1.0f / l0, i1 = lam / l1;
    float ss = 0.f;
#pragma unroll
    for (int mt = 0; mt < 2; ++mt)
#pragma unroll
        for (int i = 0; i < 16; ++i) { const float o = O[0][mt][i] * i0 - O[1][mt][i] * i1; O[0][mt][i] = o; ss += o * o; }
    ss += __shfl_xor(ss, 32);
    const float rr = rsqrtf(ss * (1.0f / 64.0f) + 1e-6f) * post_scale;
    const float* sg = p.diff_subln_g + l * 64;
    bf16_t* orow = p.MIX + (out_row0 + w * 32 + r) * D + 512 + vh * 64;
#pragma unroll
    for (int mt = 0; mt < 2; ++mt)
#pragma unroll
        for (int g4 = 0; g4 < 4; ++g4) { const int dv = 32 * mt + 8 * g4 + 4 * h; const f32x4 gg = *(const f32x4*)(sg + dv);
            u32x2 o; o.x = pk2(O[0][mt][4 * g4] * rr * gg.x, O[0][mt][4 * g4 + 1] * rr * gg.y); o.y = pk2(O[0][mt][4 * g4 + 2] * rr * gg.z, O[0][mt][4 * g4 + 3] * rr * gg.w);
            *(u32x2*)(orow + dv) = o; }
}

__device__ __forceinline__ void na_attn_wave(const bf16_t* qrow, const unsigned char* kvb, bool local, int r, int r0, int qcol, const LAS float* rpbh, bf16_t* orow) {
    const int lane = tid_now() & 63, h = lane >> 5;
    bf16x8 qf[4];
#pragma unroll
    for (int ks = 0; ks < 4; ++ks) qf[ks] = *(const bf16x8*)(qrow + ks * 16 + h * 8);
    f32x16 O[2];
#pragma unroll
    for (int c = 0; c < 2; ++c)
#pragma unroll
        for (int i = 0; i < 16; ++i) O[c][i] = 0.f;
    float m = -3.0e38f, l = 0.f;
    const int nch = local ? 24 : 8;
    const int c0 = min(max(qcol - 8, 0), 48);
    bf16x8 kf[4], vf[4];
    { const unsigned char* cp = kvb + (size_t)256 * 8192 + lane * 16;
#pragma unroll
      for (int q = 0; q < 4; ++q) { kf[q] = *(const bf16x8*)(cp + q * 1024); vf[q] = *(const bf16x8*)(cp + 4096 + q * 1024); } }
    for (int i = 0; i < nch; ++i) {
        bf16x8 nk[4], nv[4];
        { const int in = i + 1 < nch ? i + 1 : i; const int ch = in < 8 ? 256 + in : 2 * r0 + (in - 8);
          const unsigned char* cp = kvb + (size_t)ch * 8192 + lane * 16;
#pragma unroll
          for (int q = 0; q < 4; ++q) { nk[q] = *(const bf16x8*)(cp + q * 1024); nv[q] = *(const bf16x8*)(cp + 4096 + q * 1024); } }
        f32x16 s;
#pragma unroll
        for (int q = 0; q < 16; ++q) s[q] = 0.f;
#pragma unroll
        for (int ks = 0; ks < 4; ++ks) s = MFMA32(kf[ks], qf[ks], s);
        if (i >= 8) {
            const int jl = (i - 8) >> 1, kc0 = ((i - 8) & 1) * 32; const int dr = r0 + jl - r + 7; const LAS float* rp = rpbh + dr * 31;
#pragma unroll
            for (int q = 0; q < 16; ++q) { const int keycol = kc0 + (q & 3) + 8 * (q >> 2) + 4 * h; const bool valid = keycol >= c0 && keycol < c0 + 16;
                const int dc = valid ? keycol - qcol + 15 : 15; const float bias = rp[dc]; s[q] = valid ? s[q] + bias : -1.0e30f; }
        }
        const float alpha = softmax_step(s, m, l);
#pragma unroll
        for (int mt = 0; mt < 2; ++mt)
#pragma unroll
            for (int q = 0; q < 16; ++q) O[mt][q] *= alpha;
        const bf16x8 p0 = pack_step<0>(s), p1 = pack_step<1>(s);
        O[0] = MFMA32(vf[0], p0, O[0]); O[0] = MFMA32(vf[1], p1, O[0]); O[1] = MFMA32(vf[2], p0, O[1]); O[1] = MFMA32(vf[3], p1, O[1]);
#pragma unroll
        for (int q = 0; q < 4; ++q) { kf[q] = nk[q]; vf[q] = nv[q]; }
    }
    const float lt = l + __shfl_xor(l, 32); const float il = 1.0f / lt;
#pragma unroll
    for (int mt = 0; mt < 2; ++mt)
#pragma unroll
        for (int g4 = 0; g4 < 4; ++g4) { const int dv = 32 * mt + 8 * g4 + 4 * h;
            u32x2 o; o.x = pk2(O[mt][4 * g4] * il, O[mt][4 * g4 + 1] * il); o.y = pk2(O[mt][4 * g4 + 2] * il, O[mt][4 * g4 + 3] * il);
            *(u32x2*)(orow + dv) = o; }
}

__device__ __forceinline__ void seq_of_row(int row0, int& n, int& p0, size_t& seqbase) {
    if (row0 < NL) { n = SEQ; seqbase = (size_t)(row0 >> 13) << 13; p0 = row0 & (SEQ - 1); }
    else { const int rc = row0 - NL; n = CTXL; seqbase = (size_t)NL + ((rc >> 8) << 8); p0 = rc & (CTXL - 1); }
}
__device__ __forceinline__ void conv_item(const Params& p, int l, int it, LAS unsigned char* lds) {
    const int tid = tid_now(); const int row0 = it * 32; int n, p0; size_t seqbase; seq_of_row(row0, n, p0, seqbase);
    LAS float* glu = (LAS float*)lds; LAS float* hb = (LAS float*)(lds + 65536);
    const int c = tid & 255, th = tid >> 8;
    for (int rr = th; rr < 62; rr += 2) { const int pp = p0 - 15 + rr; float v = 0.f;
        if (pp >= 0 && pp < n) { const bf16_t* z = p.Z + (seqbase + pp) * 768 + 256; const float a = bf2f(z[c]), g = bf2f(z[256 + c]); v = a * fast_sigmoid(g); }
        glu[rr * 256 + c] = v; }
    __syncthreads();
    float wgt[31];
#pragma unroll
    for (int k = 0; k < 31; ++k) wgt[k] = p.conv_dw[(size_t)(l * 31 + k) * 256 + c];
    const float bias = p.conv_dw_b[l * 256 + c];
#pragma unroll 2
    for (int tt = 0; tt < 16; ++tt) { const int t = th * 16 + tt; float acc = bias;
#pragma unroll
        for (int k = 0; k < 31; ++k) acc += glu[(t + k) * 256 + c] * wgt[k];
        hb[t * 256 + c] = acc; }
    __syncthreads();
    const int w8 = tid >> 6, lane = tid & 63;
    const f32x4 lg = *(const f32x4*)(p.conv_ln_g + l * 256 + lane * 4), lb = *(const f32x4*)(p.conv_ln_b + l * 256 + lane * 4);
#pragma unroll
    for (int q = 0; q < 4; ++q) { const int t = w8 * 4 + q; const f32x4 v = *(const LAS f32x4*)(hb + t * 256 + lane * 4);
        const float mean = wave_sum(v.x + v.y + v.z + v.w) * (1.0f / 256.0f); const f32x4 d = v - mean;
        const float var = wave_sum(d.x * d.x + d.y * d.y + d.z * d.z + d.w * d.w) * (1.0f / 256.0f); const float rs = rsqrtf(var + 1e-5f);
        f32x4 y = d * rs * lg + lb; y.x *= fast_sigmoid(y.x); y.y *= fast_sigmoid(y.y); y.z *= fast_sigmoid(y.z); y.w *= fast_sigmoid(y.w);
        u32x2 o; o.x = pk2(y.x, y.y); o.y = pk2(y.z, y.w); *(u32x2*)(p.MIX + (size_t)(row0 + t) * D + 256 + lane * 4) = o; }
    __syncthreads();
}
__device__ __forceinline__ void pool_item(const Params& p, int it) {
    const int tid = tid_now(); const int row0 = it * 64; int n, p0; size_t seqbase; seq_of_row(row0, n, p0, seqbase);
    const int c2 = tid & 127, tq = tid >> 7; const int hw = 1 << (c2 >> 5);
    for (int tt = 0; tt < 16; ++tt) { const int pp = p0 + tq * 16 + tt; const int lo = max(pp - hw, 0), hi = min(pp + hw, n); float s0 = 0.f, s1 = 0.f;
        for (int q = lo; q < hi; ++q) { const unsigned u = *(const unsigned*)(p.Z + (seqbase + q) * 768 + 2 * c2); s0 += bflo(u); s1 += bfhi(u); }
        const float inv = 1.0f / (float)(hi - lo); const unsigned us = *(const unsigned*)(p.Z + (seqbase + pp) * 768 + 2 * c2);
        *(unsigned*)(p.MIX + (seqbase + pp) * D + 2 * c2) = pk2(s0 * inv - bflo(us), s1 * inv - bfhi(us)); }
}

__device__ __forceinline__ void mixers_phase(const Params& p, int l, LAS unsigned char* lds) {
    const int tid = tid_now(), bid = blockIdx.x, G = gridDim.x, w = tid >> 6, lane = tid & 63;
    const bool need_ctx = (l == 0);
    float lam, lam_init = l == 0 ? 0.2f : (0.8f - 0.6f * 0.7408182206817179f);
    { const float* lp = p.diff_lambda + l * 128; float s01 = 0.f, s23 = 0.f;
      for (int i = 0; i < 32; ++i) { s01 += lp[i] * lp[32 + i]; s23 += lp[64 + i] * lp[96 + i]; }
      lam = expf(s01) - expf(s23) + lam_init; }
    LAS float* rpbL = (LAS float*)(lds + 122880);
    for (int i = tid; i < 4 * 465; i += 512) rpbL[i] = p.na_rpb[(size_t)l * 4 * 465 + i] * LOG2E;
    __syncthreads();
    const int nun = need_ctx ? 264 : 256;
#ifdef PROBE_DIFF2
    for (int rep = 0; rep < 2; ++rep)
#endif
    for (int u = bid; u < nun; u += G) {
        int b, vh, q0, tlo; const bf16_t *Q0, *Q1; size_t orow;
        if (u < 256) { b = u >> 7; vh = (u >> 5) & 3; q0 = (u & 31) * 256; tlo = 0; orow = (size_t)b * SEQ + q0; }
        else { const int uu = u - 256; b = uu >> 2; vh = uu & 3; q0 = SEQ; tlo = 128; orow = (size_t)NL + b * CTXL; }
        Q0 = p.DQ + (size_t)(b * 8 + 2 * vh) * NKEY * 32; Q1 = Q0 + (size_t)NKEY * 32;
        diff_attn_unit(p, l, lds, b, vh, Q0, Q1, q0, tlo, 132, orow, lam, 1.0f - lam_init);
    }
#ifdef PROBE_NA2
    for (int rep = 0; rep < 2; ++rep)
#endif
    for (int u = bid; u < nun; u += G) {
        int b, head, r, r0, qcol; bool local; const bf16_t* qrow; bf16_t* orow; size_t qtok;
        if (u < 256) { b = u >> 7; r = u & 127; head = w >> 1; r0 = min(max(r - 4, 0), 120); qcol = (w & 1) * 32 + (lane & 31); local = true; const size_t tok = (size_t)r * 64 + qcol;
            qtok = tok; orow = p.MIX + ((size_t)b * SEQ + tok) * D + 768 + head * 64; }
        else { const int uu = u - 256; b = uu >> 2; head = uu & 3; r = 0; r0 = 0; qcol = 0; local = false; const int q = w * 32 + (lane & 31);
            qtok = SEQ + q; orow = p.MIX + ((size_t)NL + b * CTXL + q) * D + 768 + head * 64; }
        qrow = p.NQ + ((size_t)(b * 4 + head) * NKEY + qtok) * 64;
        na_attn_wave(qrow, (const unsigned char*)p.KV + NKV_BYTES + (size_t)(b * 4 + head) * NCHUNK * 8192, local, r, r0, qcol, rpbL + head * 465, orow);
    }
    __syncthreads();
    const int nconv = need_ctx ? NT / 32 : NL / 32, npool = need_ctx ? NT / 64 : NL / 64;
#ifdef PROBE_CONV2
    for (int rep = 0; rep < 2; ++rep)
#endif
    for (int it = bid; it < nconv; it += G) conv_item(p, l, it, lds);
    for (int it = bid; it < npool; it += G) pool_item(p, it);
}
template <class T> __device__ __forceinline__ T* lds_ptr(const LAS unsigned* pl, int idx) {
    const unsigned lo = __builtin_amdgcn_readfirstlane(pl[2 * idx]), hi = __builtin_amdgcn_readfirstlane(pl[2 * idx + 1]);
    return (T*)(((unsigned long long)hi << 32) | lo);
}
#define LP(f) p.f = lds_ptr<std::remove_pointer<decltype(p.f)>::type>(pl, (int)(offsetof(Params, f) / 8));
__device__ __forceinline__ void run_phase(const LAS unsigned* pl, int ph, LAS unsigned char* lds) {
    const int bid = blockIdx.x, G = gridDim.x; Params p;
    if (ph == 0) { LP(c) LP(c_ctx) LP(w_mod) LP(b_mod) LP(ffn_in) LP(ffn_out) LP(w_in) LP(w_out) LP(pool_w) LP(pool_scale) LP(conv_pw) LP(conv_pw_b) LP(WTfi) LP(WTfo) LP(WTin) LP(WTout) LP(MOD) LP(ROPE) LP(ZBIAS)
        prep_phase(p, lds); return; }
    if (ph == 21) { LP(X) LP(g_final) LP(out) final_phase(p); return; }
    const int l = (ph - 1) / 10, s = (ph - 1) % 10; const int Mx = (l == 0) ? NT : NL;
    switch (s) {
    case 0: case 3: case 7: { LP(g_norm) LP(x) LP(ctx) LP(X) LP(MOD) LP(Y) LP(PART) LP(ZBIAS)
        const int nkc = s == 3 ? 11 : s == 7 ? (l == 0 ? 4 : 0) : (l == 0 ? 0 : 11);
        norm_phase(p, l, s == 0 ? 0 : s == 3 ? 1 : 2, s == 7 ? 6 : s, s == 7 ? Mx : NT, l == 0 && s == 0, nkc,
                   p.MOD + (size_t)(l * 3 + 2) * NMOD * D + 5 * D, (s == 7 && l == 0) ? p.ZBIAS + l * D : nullptr); } break;
    case 1: case 8: { LP(Y) LP(WTfi) LP(H) const int f = s == 1 ? 0 : 1; Gemm g; g.A = p.Y; g.Bt = p.WTfi + (size_t)(l * 2 + f) * 2 * DFF * D; g.M = s == 1 ? NT : Mx; g.N = 2 * DFF; g.K = D; g.lda = D; g.ldb = D; g.apn = 0;
        pg8::StaticOrder S; S.init(g.M, g.N, G, bid); EpiSwiglu E; E.H = p.H;
        pg8::gemm_phase<EpiSwiglu, pg8::StaticOrder, true, true>(lds, g, S, E); } break;
    case 2: case 6: case 9: { LP(ZBIAS) LP(MIX) LP(WTout) LP(H) LP(WTfo) LP(X) LP(x) LP(MOD) LP(PART) Gemm g; EpiResid E; E.X = p.X; E.xl = p.x; E.first = (l == 0 && s == 2) ? 1 : 0;
        E.bo = p.ZBIAS + (s == 6 ? l : 2) * D;
        if (s == 6) { g.A = p.MIX; g.Bt = p.WTout + (size_t)l * D * D; g.K = D; g.lda = D; g.ldb = D; g.apn = 0; E.mod = p.MOD + (size_t)l * 3 * NMOD * D + 5 * D; E.coef = 1.0f; }
        else { const int f = s == 2 ? 0 : 1; g.A = p.H; g.Bt = p.WTfo + (size_t)(l * 2 + f) * D * DFF; g.K = DFF; g.lda = DFF; g.ldb = DFF; g.apn = 0;
               E.mod = p.MOD + (size_t)l * 3 * NMOD * D + (s == 2 ? 2 : 8) * D; E.coef = 0.5f; }
        g.M = NL; g.N = D; pg8::StaticOrder S; S.init(g.M, g.N, G, bid);
        pg8::gemm_phase<EpiResid, pg8::StaticOrder, true, true>(lds, g, S, E);
#ifdef PROBE_RESID2
        if (PROBE_RESID2(s)) { E.coef = 0.f; E.first = 0; pg8::gemm_phase<EpiResid, pg8::StaticOrder, true, true>(lds, g, S, E); }
#endif
        if (s == 2 || l == 0) {
            const int nsub = 8 * (g.K / 256); const int kc = bid / 8;
            Gemm g2; g2.A = g.A + (size_t)NL * g.lda + kc * 256; g2.Bt = g.Bt + kc * 256; g2.M = 512; g2.N = D; g2.K = 256; g2.lda = g.lda; g2.ldb = g.ldb; g2.apn = 0;
            pg8::StaticOrder S2; S2.init(512, D, 8, bid < nsub ? (bid & 7) : 8);
            EpiResidPartial E2; E2.P = p.PART + (size_t)kc * 512 * D; E2.gate = E.mod + (size_t)2 * NMOD * D; E2.coef = E.coef;
            pg8::gemm_phase<EpiResidPartial, pg8::StaticOrder, true, true>(lds, g2, S2, E2); }
        } break;
#ifndef SKIP_Z
    case 4: { LP(Y) LP(WTin) LP(Z) LP(DQ) LP(NQ) LP(KV) LP(ROPE) Gemm g; g.A = p.Y; g.Bt = p.WTin + (size_t)l * DIN * D; g.M = NT; g.N = DIN; g.K = D; g.lda = D; g.ldb = D; g.apn = 0;
        pg8::StaticOrder S; S.init(g.M, g.N, G, bid);
        EpiZ E; E.Z = p.Z; E.DQ = p.DQ; E.NQ = p.NQ; E.KV = p.KV; E.rope = p.ROPE;
        pg8::gemm_phase<EpiZ, pg8::StaticOrder, true, true>(lds, g, S, E); } break;
#endif
#ifndef SKIP_MIX
    case 5: { LP(diff_lambda) LP(na_rpb) LP(DQ) LP(NQ) LP(KV) LP(MIX) LP(diff_subln_g) LP(Z) LP(conv_dw) LP(conv_dw_b) LP(conv_ln_g) LP(conv_ln_b)
        mixers_phase(p, l, lds); } break;
#endif
    default: break;
    }
}

struct RawParams { unsigned w[sizeof(Params) / 4]; };
__global__ void __launch_bounds__(512) mega_fwd(const Params p) {
    extern __shared__ __attribute__((aligned(16))) unsigned char smem[];
    LAS unsigned char* lds = (LAS unsigned char*)smem;
    LAS unsigned* pl = (LAS unsigned*)(lds + 131072);
    { const RawParams raw = __builtin_bit_cast(RawParams, p);
#pragma unroll
      for (int i = 0; i < (int)(sizeof(Params) / 4); ++i) pl[i] = raw.w[i]; }
    __syncthreads();
    cg::grid_group grid = cg::this_grid();
    const int ph_lo = p.ph_lo, ph_hi = p.ph_hi;
    unsigned* bar = (unsigned*)p.BAR;
    if (blockIdx.x == 0 && threadIdx.x == 0) { __hip_atomic_store(bar, 0u, __ATOMIC_RELAXED, __HIP_MEMORY_SCOPE_AGENT); __hip_atomic_store(bar + 64, 0u, __ATOMIC_RELAXED, __HIP_MEMORY_SCOPE_AGENT); }
#ifdef PROBE_SYNC20
    for (int i = 0; i < 20; ++i) grid.sync();
#endif
    unsigned nbar = 0;
    for (int ph = ph_lo; ph < ph_hi; ++ph) {
        run_phase(pl, ph, lds);
#ifdef PROBE_DUP
        if (PROBE_DUP(ph)) { grid.sync(); run_phase(pl, ph, lds); }
#endif
        if (ph + 1 < ph_hi) {
            if (ph == ph_lo) grid.sync();
            else {
                ++nbar;
                __syncthreads();
                if (threadIdx.x == 0) {
                    __builtin_amdgcn_fence(__ATOMIC_RELEASE, "agent");
                    asm volatile("s_waitcnt vmcnt(0)" ::: "memory");
                    const unsigned prev = __hip_atomic_fetch_add(bar, 1u, __ATOMIC_RELAXED, __HIP_MEMORY_SCOPE_AGENT);
                    if (prev + 1u == nbar * gridDim.x) __hip_atomic_store(bar + 64, nbar, __ATOMIC_RELAXED, __HIP_MEMORY_SCOPE_AGENT);
                    else while (__hip_atomic_load(bar + 64, __ATOMIC_RELAXED, __HIP_MEMORY_SCOPE_AGENT) < nbar) __builtin_amdgcn_s_sleep(1);
                    __builtin_amdgcn_fence(__ATOMIC_ACQUIRE, "agent");
                    asm volatile("s_waitcnt vmcnt(0)" ::: "memory");
                }
                __syncthreads();
            }
        }
    }
}

extern "C" void kernel_launch(void* const* d_in, const int* in_sizes, int n_in, void* d_out, int out_size, void* d_ws, size_t ws_size, hipStream_t stream) {
    static int grid_blocks = 0;
    if (!grid_blocks) {
        int dev = 0, cus = 0, per_cu = 0;
        (void)hipGetDevice(&dev);
        (void)hipDeviceGetAttribute(&cus, hipDeviceAttributeMultiprocessorCount, dev);
        if (hipFuncSetAttribute((const void*)mega_fwd, hipFuncAttributeMaxDynamicSharedMemorySize, LDS_ALLOC) != hipSuccess) fprintf(stderr, "hipFuncSetAttribute failed\n");
        if (hipOccupancyMaxActiveBlocksPerMultiprocessor(&per_cu, (const void*)mega_fwd, 512, LDS_ALLOC) != hipSuccess || per_cu < 1) { fprintf(stderr, "occupancy query: %d\n", per_cu); per_cu = 1; }
        (void)hipGetLastError();
        grid_blocks = cus * per_cu;
    }
    Params p{};
    const float** ins = (const float**)&p;
    for (int i = 0; i < 23; ++i) ins[i] = (const float*)d_in[i];
    p.out = (float*)d_out;
    size_t off = 0;
    auto take = [&](size_t bytes) { void* r = (char*)d_ws + off; off += (bytes + 255) & ~(size_t)255; return r; };
    p.WTfi = (bf16_t*)take((size_t)4 * 2 * DFF * D * 2); p.WTfo = (bf16_t*)take((size_t)4 * D * DFF * 2); p.WTin = (bf16_t*)take((size_t)2 * DIN * D * 2);
    p.WTout = (bf16_t*)take((size_t)2 * D * D * 2);
    p.MOD = (float*)take((size_t)2 * 3 * NMOD * D * 4); p.ROPE = (float*)take(2048 * 4); p.BAR = (float*)take(1024); p.ZBIAS = (float*)take(3 * 1024 * 4); p.X = (float*)take((size_t)NT * D * 4); p.PART = (float*)take((size_t)11 * 512 * D * 4); p.Y = (bf16_t*)take((size_t)NT * D * 2);
    const size_t reg0 = off;
    p.H = (bf16_t*)take((size_t)NT * DFF * 2);
    const size_t hend = off; off = reg0;
    p.Z = (bf16_t*)take((size_t)NT * 768 * 2); p.DQ = (bf16_t*)take((size_t)2 * 8 * NKEY * 32 * 2); p.NQ = (bf16_t*)take((size_t)2 * 4 * NKEY * 64 * 2); p.KV = (bf16_t*)take(2 * NKV_BYTES);
    p.MIX = (bf16_t*)take((size_t)NT * D * 2);
    if (off < hend) off = hend;
    if (off > ws_size) { fprintf(stderr, "workspace too small: need %zu have %zu\n", off, ws_size); return; }
#if MK_SPLIT
    for (int ph = 0; ph < 22; ++ph) { Params q = p; q.ph_lo = ph; q.ph_hi = ph + 1; void* args[] = {&q};
        hipError_t e = hipLaunchCooperativeKernel((const void*)mega_fwd, dim3(grid_blocks), dim3(512), args, LDS_ALLOC, stream);
        if (e != hipSuccess) fprintf(stderr, "launch failed: %s\n", hipGetErrorString(e)); }
#else
    p.ph_lo = 0; p.ph_hi = 22;
    void* args[] = {&p};
    hipError_t e = hipLaunchCooperativeKernel((const void*)mega_fwd, dim3(grid_blocks), dim3(512), args, LDS_ALLOC, stream);
    if (e != hipSuccess) fprintf(stderr, "cooperative launch failed: %s (grid %d)\n", hipGetErrorString(e), grid_blocks);
#endif
}
```
